# Optimizing an MI355X kernel written in HIP

```python
import math
import jax, jax.numpy as jnp
from jax import lax
import numpy as np

D_MODEL = 2048
BATCH = 4
SEQ = 2048
DEPTH = 1
DEC_BATCH = 32
DEC_SEQ = 1
PAST_LEN = 16384
PAGE_SIZE = 128

HEAD_DIM = 64
N_HEADS = D_MODEL // 128
N_KV_HEADS = 4
GQA_GROUP = N_HEADS // N_KV_HEADS
WINDOW = 128
ATTN_BLOCK = WINDOW
ATTN_W = N_HEADS * HEAD_DIM
KV_W = N_KV_HEADS * HEAD_DIM
CHUNK = 128
GM_GROUPS = 4
GM_W = D_MODEL // 2
GM_GROUP_W = GM_W // GM_GROUPS
D_FF = (11 * D_MODEL) // 4
CONV_W = 3
PLE_DIM = 256
IN_W = ATTN_W + 2 * KV_W + 2 * GM_W
SPLITS = (ATTN_W, ATTN_W + KV_W, ATTN_W + 2 * KV_W, ATTN_W + 2 * KV_W + GM_W)
EPS = 1e-6
MASK_VALUE = -1e30

kernel_name = "hybrid_swa_sgu_convffn_decode_step"


def rmsnorm(x, w):
    xf = x.astype(jnp.float32)
    y = xf * lax.rsqrt(jnp.mean(xf * xf, axis=-1, keepdims=True) + EPS)
    return (y * w.astype(jnp.float32)).astype(x.dtype)


def layernorm(x, w):
    xf = x.astype(jnp.float32)
    mu = jnp.mean(xf, axis=-1, keepdims=True)
    xc = xf - mu
    y = xc * lax.rsqrt(jnp.mean(xc * xc, axis=-1, keepdims=True) + EPS)
    return (y * w.astype(jnp.float32)).astype(x.dtype)


def alibi_slopes():
    h = jnp.arange(1, N_HEADS + 1, dtype=jnp.float32)
    return jnp.exp2(-8.0 * h / N_HEADS)


def sink_attention(q, k, v, dist, valid, sinks):
    s = jnp.einsum('...ikgd,...jkd->...kgij', q, k).astype(jnp.float32) * (HEAD_DIM ** -0.5)
    slopes = alibi_slopes().reshape(N_KV_HEADS, GQA_GROUP, 1, 1)
    s = s - slopes * dist.astype(jnp.float32)
    s = jnp.where(valid, s, MASK_VALUE)
    sink_col = jnp.broadcast_to(sinks.astype(jnp.float32).reshape(N_KV_HEADS, GQA_GROUP, 1, 1), s.shape[:-1] + (1,))
    probs = jax.nn.softmax(jnp.concatenate([s, sink_col], axis=-1), axis=-1)[..., :-1]
    return jnp.einsum('...kgij,...jkd->...ikgd', probs.astype(v.dtype), v)


def attn_prompt(q, k, v, sinks):
    B, L = q.shape[:2]
    nb = L // ATTN_BLOCK
    qb = q.reshape(B, nb, ATTN_BLOCK, N_KV_HEADS, GQA_GROUP, HEAD_DIM)
    pad = jnp.zeros((B, ATTN_BLOCK, N_KV_HEADS, HEAD_DIM), k.dtype)
    kb = jnp.concatenate([pad, k], axis=1).reshape(B, nb + 1, ATTN_BLOCK, N_KV_HEADS, HEAD_DIM)
    vb = jnp.concatenate([pad, v], axis=1).reshape(B, nb + 1, ATTN_BLOCK, N_KV_HEADS, HEAD_DIM)
    kk = jnp.concatenate([kb[:, :-1], kb[:, 1:]], axis=2)
    vv = jnp.concatenate([vb[:, :-1], vb[:, 1:]], axis=2)
    i = jnp.arange(ATTN_BLOCK)[:, None]
    j = jnp.arange(2 * ATTN_BLOCK)[None, :]
    dist = ATTN_BLOCK + i - j
    c = jnp.arange(nb)[:, None, None]
    valid = (dist >= 0) & (dist <= WINDOW) & (c * ATTN_BLOCK + j - ATTN_BLOCK >= 0)
    out = sink_attention(qb, kk, vv, dist, valid[:, None, None], sinks)
    return out.reshape(B, L, ATTN_W), k[:, -WINDOW:], v[:, -WINDOW:]


def attn_sample(q, k, v, k_buf, v_buf, sinks):
    B, T = q.shape[:2]
    kk = jnp.concatenate([k_buf, k], axis=1)
    vv = jnp.concatenate([v_buf, v], axis=1)
    i = jnp.arange(T)[:, None]
    j = jnp.arange(WINDOW + T)[None, :]
    dist = WINDOW + i - j
    valid = (dist >= 0) & (dist <= WINDOW)
    qg = q.reshape(B, T, N_KV_HEADS, GQA_GROUP, HEAD_DIM)
    out = sink_attention(qg, kk, vv, dist, valid, sinks)
    return out.reshape(B, T, ATTN_W), kk[:, T:], vv[:, T:]


def spatial_mix(vg, w_s, b_s):
    Lc = vg.shape[2]
    mask = jnp.tril(jnp.ones((Lc, Lc), dtype=bool))
    w = jnp.where(mask, w_s[:, :Lc, :Lc], 0).astype(vg.dtype)
    bias = jnp.transpose(b_s[:, :Lc])[:, :, None].astype(vg.dtype)
    return jnp.einsum('gts,bcsgd->bctgd', w, vg) + bias


def layer(x, p, k_buf, v_buf, conv_buf, lw, is_prompt):
    B, L, _ = x.shape
    xn = rmsnorm(x, lw['attn_norm_w'])
    proj = xn @ lw['w_in']
    q, k, v, gu, gv = jnp.split(proj, SPLITS, axis=-1)
    q = rmsnorm(q.reshape(B, L, N_HEADS, HEAD_DIM), lw['q_norm_w'])
    k = rmsnorm(k.reshape(B, L, N_KV_HEADS, HEAD_DIM), lw['k_norm_w'])
    v = v.reshape(B, L, N_KV_HEADS, HEAD_DIM)
    if is_prompt:
        attn, k_new, v_new = attn_prompt(q, k, v, lw['attn_sinks'])
        n_chunks, chunk_len = L // CHUNK, CHUNK
    else:
        attn, k_new, v_new = attn_sample(q, k, v, k_buf, v_buf, lw['attn_sinks'])
        n_chunks, chunk_len = 1, L
    gu = jax.nn.gelu(gu)
    gv = layernorm(jax.nn.gelu(gv), lw['sgu_norm_w'])
    vg = gv.reshape(B, n_chunks, chunk_len, GM_GROUPS, GM_GROUP_W)
    sgu = gu * spatial_mix(vg, lw['sgu_w'], lw['sgu_b']).reshape(B, L, GM_W)
    sgu_state = gv[:, -chunk_len:]
    branch_attn = attn @ lw['w_br_attn']
    branch_sgu = sgu @ lw['w_br_gm']
    gates = jax.nn.sigmoid(xn @ lw['w_gate'] + lw['b_gate'])
    merged = gates[..., D_MODEL:] * branch_attn + gates[..., :D_MODEL] * branch_sgu
    x = x + merged @ lw['w_out']
    h = rmsnorm(x, lw['ffn_norm_w']) @ lw['w_up']
    if conv_buf is None:
        conv_buf = jnp.zeros((B, CONV_W - 1, 2 * D_FF), h.dtype)
    hp = jnp.concatenate([conv_buf, h], axis=1)
    cw = lw['conv_w']
    hc = cw[0] * hp[:, 0:L] + cw[1] * hp[:, 1:L + 1] + cw[2] * hp[:, 2:L + 2] + lw['conv_b']
    hg, hu = jnp.split(hc, 2, axis=-1)
    x = x + (jax.nn.silu(hg) * hu) @ lw['w_down']
    conv_state = hp[:, -(CONV_W - 1):]
    ple_gate = jax.nn.sigmoid(rmsnorm(x, lw['ple_norm_w']) @ lw['w_ple_gate'])
    x = x + ple_gate * (p @ lw['w_ple_proj'])
    return x, k_new, v_new, sgu_state, conv_state


def setup_inputs(seed: int = 0) -> dict:
    key = jax.random.key(seed)
    ks = iter(jax.random.split(key, 40))

    def nrm(shape, scale=1.0):
        return jax.random.normal(next(ks), shape, jnp.float32) * scale

    def gain(shape):
        return 1.0 + nrm(shape, 0.05)

    return {
        'x_prompt': nrm((BATCH, SEQ, D_MODEL)),
        'x_sample': nrm((DEC_BATCH, DEC_SEQ, D_MODEL)),
        'p_prompt': nrm((DEPTH, BATCH, SEQ, PLE_DIM)),
        'p_sample': nrm((DEPTH, DEC_BATCH, DEC_SEQ, PLE_DIM)),
        'state_attn_k': nrm((DEPTH, DEC_BATCH, WINDOW, N_KV_HEADS, HEAD_DIM)),
        'state_attn_v': nrm((DEPTH, DEC_BATCH, WINDOW, N_KV_HEADS, HEAD_DIM)),
        'state_conv': nrm((DEPTH, DEC_BATCH, CONV_W - 1, 2 * D_FF)),
        'attn_norm_w': gain((DEPTH, D_MODEL)),
        'w_in': nrm((DEPTH, D_MODEL, IN_W), D_MODEL ** -0.5),
        'q_norm_w': gain((DEPTH, HEAD_DIM)),
        'k_norm_w': gain((DEPTH, HEAD_DIM)),
        'attn_sinks': nrm((DEPTH, N_HEADS), 0.5),
        'sgu_norm_w': gain((DEPTH, GM_W)),
        'sgu_w': nrm((DEPTH, GM_GROUPS, CHUNK, CHUNK), 0.5 * CHUNK ** -0.5),
        'sgu_b': 1.0 + nrm((DEPTH, GM_GROUPS, CHUNK), 0.02),
        'w_br_attn': nrm((DEPTH, ATTN_W, D_MODEL), ATTN_W ** -0.5),
        'w_br_gm': nrm((DEPTH, GM_W, D_MODEL), GM_W ** -0.5),
        'w_gate': nrm((DEPTH, D_MODEL, 2 * D_MODEL), D_MODEL ** -0.5),
        'b_gate': nrm((DEPTH, 2 * D_MODEL), 0.02),
        'w_out': nrm((DEPTH, D_MODEL, D_MODEL), D_MODEL ** -0.5),
        'ffn_norm_w': gain((DEPTH, D_MODEL)),
        'w_up': nrm((DEPTH, D_MODEL, 2 * D_FF), D_MODEL ** -0.5),
        'conv_w': nrm((DEPTH, CONV_W, 2 * D_FF), CONV_W ** -0.5),
        'conv_b': nrm((DEPTH, 2 * D_FF), 0.02),
        'w_down': nrm((DEPTH, D_FF, D_MODEL), D_FF ** -0.5),
        'ple_norm_w': gain((DEPTH, D_MODEL)),
        'w_ple_gate': nrm((DEPTH, D_MODEL, D_MODEL), D_MODEL ** -0.5),
        'w_ple_proj': nrm((DEPTH, PLE_DIM, D_MODEL), PLE_DIM ** -0.5),
    }


def reference(x_prompt, x_sample, p_prompt, p_sample, state_attn_k, state_attn_v, state_conv,
              attn_norm_w, w_in, q_norm_w, k_norm_w, attn_sinks, sgu_norm_w, sgu_w, sgu_b,
              w_br_attn, w_br_gm, w_gate, b_gate, w_out, ffn_norm_w, w_up, conv_w, conv_b,
              w_down, ple_norm_w, w_ple_gate, w_ple_proj):
    xp, xs = x_prompt, x_sample
    kp_l, vp_l, ks_l, vs_l, gp_l, gs_l, cp_l, cs_l = [], [], [], [], [], [], [], []
    for i in range(DEPTH):
        lw = {
            'attn_norm_w': attn_norm_w[i], 'w_in': w_in[i], 'q_norm_w': q_norm_w[i],
            'k_norm_w': k_norm_w[i], 'attn_sinks': attn_sinks[i], 'sgu_norm_w': sgu_norm_w[i],
            'sgu_w': sgu_w[i], 'sgu_b': sgu_b[i], 'w_br_attn': w_br_attn[i], 'w_br_gm': w_br_gm[i],
            'w_gate': w_gate[i], 'b_gate': b_gate[i], 'w_out': w_out[i], 'ffn_norm_w': ffn_norm_w[i],
            'w_up': w_up[i], 'conv_w': conv_w[i], 'conv_b': conv_b[i], 'w_down': w_down[i],
            'ple_norm_w': ple_norm_w[i], 'w_ple_gate': w_ple_gate[i], 'w_ple_proj': w_ple_proj[i],
        }
        xp, kp, vp, gp, cp = layer(xp, p_prompt[i], None, None, None, lw, True)
        xs, ksn, vsn, gs, cs = layer(xs, p_sample[i], state_attn_k[i], state_attn_v[i], state_conv[i], lw, False)
        kp_l.append(kp); vp_l.append(vp); ks_l.append(ksn); vs_l.append(vsn)
        gp_l.append(gp); gs_l.append(gs); cp_l.append(cp); cs_l.append(cs)
    attn_k_prompt = jnp.stack(kp_l)
    attn_v_prompt = jnp.stack(vp_l)
    attn_k_sample = jnp.stack(ks_l)
    attn_v_sample = jnp.stack(vs_l)
    sgu_v_prompt = jnp.stack(gp_l)
    sgu_v_sample = jnp.stack(gs_l)
    conv_prompt = jnp.stack(cp_l)
    conv_sample = jnp.stack(cs_l)
    return (xp, xs, attn_k_prompt, attn_v_prompt, attn_k_sample, attn_v_sample, sgu_v_prompt, sgu_v_sample, conv_prompt, conv_sample)
```

```cpp
#include <hip/hip_runtime.h>
#include <hip/hip_cooperative_groups.h>
#include <cstdio>
#include <cstdint>
namespace cg = cooperative_groups;

#define LAS __attribute__((address_space(3)))
typedef unsigned short bf16;
typedef unsigned u32x4 __attribute__((ext_vector_type(4)));
typedef unsigned u32x2 __attribute__((ext_vector_type(2)));
typedef float f32x4 __attribute__((ext_vector_type(4)));
typedef short bf16x8 __attribute__((ext_vector_type(8)));

constexpr int DM = 2048, MP = 8192, MS = 32, MALL = MP + MS, SEQ = 2048;
constexpr int N1 = 7680, DFF = 5632, NUP = 11264, PLE = 256;
constexpr int C_K = 1024, C_V = 1280, C_GU = 1536, C_GV = 2560, C_GATE = 3584;
constexpr float EPS = 1e-6f;
constexpr size_t OFF_Y = 0, OFF_KP = 16842752, OFF_VP = 16973824, OFF_KS = 17104896, OFF_VS = 18153472,
                 OFF_GP = 19202048, OFF_GS = 19726336, OFF_CP = 19759104, OFF_CS = 19849216, OUT_TOTAL = 20570112;
constexpr size_t MiB = 1u << 20;
constexpr size_t WS_WUP = 1 * MiB, WS_WDOWN = 45 * MiB, WS_WPG = 67 * MiB, WS_WPP = 75 * MiB, WS_XN = 76 * MiB;
constexpr size_t WS_W1 = 109 * MiB, WS_WBA = 139 * MiB, WS_WBG = 143 * MiB, WS_WOUT = 147 * MiB;
constexpr size_t WS_PROJ = 155 * MiB, WS_MIX = 276 * MiB, WS_MERGED = 309 * MiB, WS_PBF = 342 * MiB;
constexpr size_t WS_BAR = 262144;
constexpr size_t WS_SS1 = 0, WS_SS2 = 65536, WS_XN3 = 254 * MiB, WS_HB = 109 * MiB, WS_HS = 116 * MiB;
constexpr size_t WS_ACT = 165 * MiB, WS_PP = 118 * MiB, WS_END = 347 * MiB;
static_assert(WS_PROJ + (size_t)MALL * N1 * 2 <= WS_MIX && WS_MIX + (size_t)MALL * 2048 * 2 <= WS_MERGED && WS_MERGED + (size_t)MALL * 2048 * 2 <= WS_PBF, "ws map early");
static_assert(WS_ACT + (size_t)MALL * DFF * 2 <= WS_XN3 && WS_XN3 + (size_t)MALL * DM * 2 <= WS_PBF && WS_PBF + (size_t)MALL * PLE * 2 <= WS_END && WS_PP + (size_t)MALL * DM * 2 <= WS_ACT && WS_HS + (size_t)MS * NUP * 4 <= WS_PP && WS_HB + (size_t)32 * 4 * NUP * 4 <= WS_HS && WS_HS + (size_t)MS * NUP * 4 <= WS_ACT, "ws map late");
constexpr int MISC_OFF = 131072 + 8192;
constexpr int WL_OFF = 131072 + 8192 + 256, RSL_OFF = WL_OFF + 4096;
constexpr int LDS_BYTES = RSL_OFF + 1024;
#ifndef DUP_PHASE
#define DUP_PHASE -1
#endif

struct Params {
    const float *x_prompt, *x_sample, *p_prompt, *p_sample, *st_k, *st_v, *st_conv;
    const float *attn_norm_w, *w_in, *q_norm_w, *k_norm_w, *sinks, *sgu_norm_w, *sgu_w, *sgu_b;
    const float *w_br_attn, *w_br_gm, *w_gate, *b_gate, *w_out, *ffn_norm_w, *w_up, *conv_w, *conv_b, *w_down, *ple_norm_w, *w_ple_gate, *w_ple_proj;
    float* out; unsigned char* ws;
};

typedef const __attribute__((address_space(4))) Params* KP;
__device__ __forceinline__ KP kargs() { KP k = (KP)__builtin_amdgcn_kernarg_segment_ptr(); asm volatile("" : "+s"(k)); return k; }

__device__ __forceinline__ int tid_fresh() { int t = threadIdx.x; asm volatile("" : "+v"(t)); return t; }
typedef float f32x2_t __attribute__((ext_vector_type(2)));
typedef __bf16 bf16x2_t __attribute__((ext_vector_type(2)));
__device__ __forceinline__ unsigned pk2m(float lo, float hi) { f32x2_t v = {lo, hi}; bf16x2_t b = __builtin_convertvector(v, bf16x2_t); return __builtin_bit_cast(unsigned, b); }
__device__ __forceinline__ unsigned pk2(float lo, float hi) { unsigned r; asm("v_cvt_pk_bf16_f32 %0, %1, %2" : "=v"(r) : "v"(lo), "v"(hi)); return r; }
__device__ __forceinline__ float bf_lo(unsigned u) { return __builtin_bit_cast(float, u << 16); }
__device__ __forceinline__ float bf_hi(unsigned u) { return __builtin_bit_cast(float, u & 0xffff0000u); }
__device__ __forceinline__ void unpack8(const u32x4 u, float (&f)[8]) {
    f[0] = bf_lo(u.x); f[1] = bf_hi(u.x); f[2] = bf_lo(u.y); f[3] = bf_hi(u.y); f[4] = bf_lo(u.z); f[5] = bf_hi(u.z); f[6] = bf_lo(u.w); f[7] = bf_hi(u.w);
}
__device__ __forceinline__ u32x4 pack8m(const float (&f)[8]) { u32x4 u; u.x = pk2m(f[0], f[1]); u.y = pk2m(f[2], f[3]); u.z = pk2m(f[4], f[5]); u.w = pk2m(f[6], f[7]); return u; }
__device__ __forceinline__ u32x4 pack8(const float (&f)[8]) { u32x4 u; u.x = pk2(f[0], f[1]); u.y = pk2(f[2], f[3]); u.z = pk2(f[4], f[5]); u.w = pk2(f[6], f[7]); return u; }
__device__ __forceinline__ float wave_sum(float v) {
#pragma unroll
    for (int o = 1; o < 64; o <<= 1) v += __shfl_xor(v, o);
    return v;
}
__device__ __forceinline__ float wave_max(float v) {
#pragma unroll
    for (int o = 1; o < 64; o <<= 1) v = fmaxf(v, __shfl_xor(v, o));
    return v;
}
__device__ __forceinline__ float sigmoidf_(float z) { return __builtin_amdgcn_rcpf(1.f + __expf(-z)); }
__device__ __forceinline__ float gelu_tanh(float x) { const float u = 0.7978845608028654f * (x + 0.044715f * x * x * x); return x * __builtin_amdgcn_rcpf(1.f + __expf(-2.f * u)); }
__device__ __forceinline__ float silu_(float x) { return x * __builtin_amdgcn_rcpf(1.f + __expf(-x)); }

namespace pg8 {
#define PG8_LAS __attribute__((address_space(3)))
typedef unsigned short bf16_t;
typedef short bf16x8 __attribute__((ext_vector_type(8)));
typedef float f32x4 __attribute__((ext_vector_type(4)));
constexpr int BM = 256, BK = 64, HALF = 128, HTB = HALF * BK * 2, STAGE_BYTES = 8 * HTB, NXCD = 8, WGM = 8;

__host__ __device__ __forceinline__ int lds_byte(int r, int c) { const int st = (r >> 4) * 2 + (c >> 5), rr = r & 15, cc = c & 31, ob = rr * 64 + cc * 2; return st * 1024 + (ob ^ (((ob >> 9) & 1) << 5)); }
__host__ __device__ __forceinline__ void stage_rc(int b, int& R, int& C) { const int st = b / 1024, sb = b % 1024, swz = sb ^ (((sb >> 9) & 1) << 5); R = (st >> 1) * 16 + swz / 64; C = (st & 1) * 32 + (swz % 64) / 2; }
__host__ __device__ __forceinline__ int perm32(int rho) { const int n = rho >> 4, i = rho & 15; return 8 * (i >> 2) + 4 * n + (i & 3); }

struct Unit { int pm, pn; };
struct Gemm { const bf16_t* A; const bf16_t* Bt; int M, N, K, lda, ldb; };

struct StaticOrder {
    int nM, nN, nwg, G, c;
    __host__ __device__ void init(int M, int N, int G_, int c_) { nM = M / BM; nN = N / BM; nwg = nM * nN; G = G_; c = c_; }
    __host__ __device__ bool next(int i, Unit& u) const {
        const long L = (long)i * G + c; if (L >= nwg) return false;
        int wgid = (int)L; { const int q = nwg / NXCD, r = nwg % NXCD, xcd = wgid % NXCD, off = wgid / NXCD; wgid = (xcd < r ? xcd * (q + 1) : r * (q + 1) + (xcd - r) * q) + off; }
        const int nig = WGM * nN, gid = wgid / nig, fm = gid * WGM, gsz = (nM - fm) < WGM ? (nM - fm) : WGM;
        u.pm = fm + ((wgid % nig) % gsz); u.pn = (wgid % nig) / gsz; return true;
    }
};

template <class Epi, class Sched, bool ALIGN_EPI = false, bool SP2 = false>
__device__ __forceinline__ void gemm_phase(PG8_LAS unsigned char* lds, const Gemm g, const Sched& S, const Epi& E) {
    const int tid = tid_fresh(), wid = __builtin_amdgcn_readfirstlane(tid >> 6), lane = tid & 63, wr = wid >> 2, wc = wid & 3, fr = lane & 15, fq = lane >> 4;
    const int K = g.K, nt = K / BK;
    unsigned voffA[2], voffB[2];
#pragma unroll
    for (int i = 0; i < 2; ++i) { int R, C; stage_rc(tid * 16 + i * 8192, R, C); const int Rb = Epi::PERM ? ((R & ~31) + perm32(R & 31)) : R;
        voffA[i] = (unsigned)(R * g.lda + C) * 2u; voffB[i] = (unsigned)(Rb * g.ldb + C) * 2u; }
    const size_t kstep = (size_t)(BK * 2);
    const size_t hstepA = (size_t)HALF * g.lda * 2, hstepB = (size_t)HALF * g.ldb * 2;
    const size_t tstepA = 2 * hstepA, tstepB = 2 * hstepB;
    const unsigned ldsw = (unsigned)wid * 1024u;
    const int aoff = lds_byte(wr * 64 + fr, fq * 8), boff = lds_byte(wc * 32 + fr, fq * 8);
#define PG8_SA(b, h) (((b) * 2 + (h)) * HTB)
#define PG8_SB(b, h) ((4 + (b) * 2 + (h)) * HTB)
#define PG8_STAGE(bufoff, gbase, voff) do { _Pragma("unroll") for (int _i = 0; _i < 2; ++_i) \
        __builtin_amdgcn_global_load_lds((const unsigned*)((const char*)(gbase) + (voff)[_i]), (PG8_LAS unsigned*)(lds + (bufoff) + ldsw + _i * 8192), 16, 0, 0); } while (0)
#define PG8_LDA(dst, b, h) do { _Pragma("unroll") for (int m = 0; m < 4; ++m) _Pragma("unroll") for (int k = 0; k < 2; ++k) dst[m][k] = *(const PG8_LAS bf16x8*)(lds + PG8_SA(b, h) + aoff + m * 2048 + k * 1024); } while (0)
#define PG8_LDB(dst, b, h) do { _Pragma("unroll") for (int n = 0; n < 2; ++n) _Pragma("unroll") for (int k = 0; k < 2; ++k) dst[n][k] = *(const PG8_LAS bf16x8*)(lds + PG8_SB(b, h) + boff + n * 2048 + k * 1024); } while (0)
#define PG8_MMA(ai, bj, At, Bt) do { __builtin_amdgcn_s_setprio(1); _Pragma("unroll") for (int m = 0; m < 4; ++m) _Pragma("unroll") for (int n = 0; n < 2; ++n) _Pragma("unroll") for (int k = 0; k < 2; ++k) \
        acc[ai][bj][m][n] = __builtin_amdgcn_mfma_f32_16x16x32_bf16(Bt[n][k], At[m][k], acc[ai][bj][m][n], 0, 0, 0); __builtin_amdgcn_s_setprio(0); } while (0)
#define PG8_WAIT_V(n) asm volatile("s_waitcnt vmcnt(" #n ")" ::: "memory")
#define PG8_WAIT_L(n) asm volatile("s_waitcnt lgkmcnt(" #n ")" ::: "memory")
#define PG8_BAR __builtin_amdgcn_s_barrier()
#define PG8_SCHED __builtin_amdgcn_sched_barrier(0)
    Unit cur, nxt; int ui = 0;
    if (!S.next(0, cur)) return;
    f32x4 acc[2][2][4][2];
#pragma unroll
    for (int a = 0; a < 2; ++a)
#pragma unroll
        for (int b = 0; b < 2; ++b)
#pragma unroll
            for (int m = 0; m < 4; ++m)
#pragma unroll
                for (int n = 0; n < 2; ++n) acc[a][b][m][n] = (f32x4){0.f, 0.f, 0.f, 0.f};
    bf16x8 At[4][2], B0[2][2], B1[2][2];
    const char* cA = (const char*)g.A + (size_t)cur.pm * tstepA; const char* cB = (const char*)g.Bt + (size_t)cur.pn * tstepB;
    if constexpr (SP2) {
        PG8_STAGE(PG8_SB(0, 0), cB, voffB); PG8_STAGE(PG8_SB(0, 1), cB + hstepB, voffB); PG8_STAGE(PG8_SA(0, 0), cA, voffA); PG8_STAGE(PG8_SA(0, 1), cA + hstepA, voffA);
        if (wr == 1) PG8_BAR;
        PG8_WAIT_V(2); PG8_BAR;
        PG8_STAGE(PG8_SB(1, 0), cB + kstep, voffB); PG8_STAGE(PG8_SA(1, 0), cA + kstep, voffA); PG8_STAGE(PG8_SB(1, 1), cB + hstepB + kstep, voffB);
        PG8_WAIT_V(6); PG8_BAR;
    } else {
        PG8_STAGE(PG8_SB(0, 0), cB, voffB); PG8_STAGE(PG8_SA(0, 0), cA, voffA); PG8_STAGE(PG8_SB(0, 1), cB + hstepB, voffB); PG8_STAGE(PG8_SA(0, 1), cA + hstepA, voffA);
        if (wr == 1) PG8_BAR;
        PG8_WAIT_V(4); PG8_BAR;
        PG8_STAGE(PG8_SB(1, 0), cB + kstep, voffB); PG8_STAGE(PG8_SA(1, 0), cA + kstep, voffA); PG8_STAGE(PG8_SB(1, 1), cB + hstepB + kstep, voffB);
        PG8_WAIT_V(6); PG8_BAR;
    }
    for (;;) {
        const bool has_next = S.next(ui + 1, nxt);
        const char* nA = has_next ? (const char*)g.A + (size_t)nxt.pm * tstepA : cA; const char* nB = has_next ? (const char*)g.Bt + (size_t)nxt.pn * tstepB : cB;
        for (int t = 0; t < nt; t += 2) {
            if constexpr (Epi::MID) { if (t == (nt >> 1)) E.mid(acc, cur); }
            const bool last = (t == nt - 2);
            const char* a1 = cA + (size_t)(t + 1) * kstep;
            const char* a2 = last ? nA : cA + (size_t)(t + 2) * kstep; const char* b2 = last ? nB : cB + (size_t)(t + 2) * kstep;
            const char* a3 = a2 + kstep; const char* b3 = b2 + kstep;
            if constexpr (SP2) {
            PG8_LDB(B0, 0, 0); PG8_LDB(B1, 0, 1); PG8_SCHED; PG8_LDA(At, 0, 0); PG8_STAGE(PG8_SA(1, 1), a1 + hstepA, voffA);
            PG8_WAIT_V(8); PG8_WAIT_L(0); PG8_BAR; PG8_MMA(0, 0, At, B0); PG8_MMA(0, 1, At, B1); PG8_BAR; PG8_SCHED;
            PG8_LDA(At, 0, 1); PG8_STAGE(PG8_SB(0, 0), b2, voffB); PG8_STAGE(PG8_SB(0, 1), b2 + hstepB, voffB); PG8_STAGE(PG8_SA(0, 0), a2, voffA);
            PG8_WAIT_V(8); PG8_WAIT_L(0); PG8_BAR; PG8_MMA(1, 0, At, B0); PG8_MMA(1, 1, At, B1); PG8_BAR; PG8_SCHED;
            PG8_LDB(B0, 1, 0); PG8_LDB(B1, 1, 1); PG8_SCHED; PG8_LDA(At, 1, 0); PG8_STAGE(PG8_SA(0, 1), a2 + hstepA, voffA);
            PG8_WAIT_V(8); PG8_WAIT_L(0); PG8_BAR; PG8_MMA(0, 0, At, B0); PG8_MMA(0, 1, At, B1); PG8_BAR; PG8_SCHED;
            PG8_LDA(At, 1, 1); PG8_STAGE(PG8_SB(1, 0), b3, voffB); PG8_STAGE(PG8_SB(1, 1), b3 + hstepB, voffB); PG8_STAGE(PG8_SA(1, 0), a3, voffA);
            PG8_WAIT_V(8); PG8_WAIT_L(0); PG8_BAR; PG8_MMA(1, 0, At, B0); PG8_MMA(1, 1, At, B1); PG8_BAR; PG8_SCHED;
            } else {
            PG8_LDB(B0, 0, 0); PG8_SCHED; PG8_LDA(At, 0, 0); PG8_STAGE(PG8_SA(1, 1), a1 + hstepA, voffA);
            PG8_WAIT_L(8); PG8_BAR; PG8_WAIT_L(0); PG8_MMA(0, 0, At, B0); PG8_BAR; PG8_SCHED;
            PG8_LDB(B1, 0, 1); PG8_STAGE(PG8_SB(0, 0), b2, voffB);
            PG8_BAR; PG8_WAIT_L(0); PG8_MMA(0, 1, At, B1); PG8_BAR;
            PG8_LDA(At, 0, 1); PG8_STAGE(PG8_SA(0, 0), a2, voffA);
            PG8_BAR; PG8_WAIT_L(0); PG8_MMA(1, 0, At, B0); PG8_BAR; PG8_SCHED;
            PG8_STAGE(PG8_SB(0, 1), b2 + hstepB, voffB);
            PG8_WAIT_V(6); PG8_BAR; PG8_MMA(1, 1, At, B1); PG8_BAR;
            PG8_LDB(B0, 1, 0); PG8_SCHED; PG8_LDA(At, 1, 0); PG8_STAGE(PG8_SA(0, 1), a2 + hstepA, voffA);
            PG8_WAIT_L(8); PG8_BAR; PG8_WAIT_L(0); PG8_MMA(0, 0, At, B0); PG8_BAR; PG8_SCHED;
            PG8_LDB(B1, 1, 1); PG8_STAGE(PG8_SB(1, 0), b3, voffB);
            PG8_BAR; PG8_WAIT_L(0); PG8_MMA(0, 1, At, B1); PG8_BAR;
            PG8_LDA(At, 1, 1); PG8_STAGE(PG8_SA(1, 0), a3, voffA);
            PG8_BAR; PG8_WAIT_L(0); PG8_MMA(1, 0, At, B0); PG8_BAR; PG8_SCHED;
            PG8_STAGE(PG8_SB(1, 1), b3 + hstepB, voffB);
            PG8_WAIT_V(6); PG8_BAR; PG8_MMA(1, 1, At, B1); PG8_BAR;
            }
        }
        if constexpr (ALIGN_EPI) { if (wr == 0) PG8_BAR; }
        E(acc, cur, wr, wc, fr, fq);
        if (!has_next) break;
#pragma unroll
        for (int a = 0; a < 2; ++a)
#pragma unroll
            for (int b = 0; b < 2; ++b)
#pragma unroll
                for (int m = 0; m < 4; ++m)
#pragma unroll
                    for (int n = 0; n < 2; ++n) acc[a][b][m][n] = (f32x4){0.f, 0.f, 0.f, 0.f};
        cur = nxt; cA = nA; cB = nB; ++ui;
        if constexpr (ALIGN_EPI) { if (wr == 1) PG8_BAR; }
    }
    PG8_WAIT_V(0);
    if constexpr (!ALIGN_EPI) { if (wr == 0) PG8_BAR; }
    PG8_BAR;
#undef PG8_SA
#undef PG8_SB
#undef PG8_STAGE
#undef PG8_LDA
#undef PG8_LDB
#undef PG8_MMA
#undef PG8_WAIT_V
#undef PG8_WAIT_L
#undef PG8_BAR
#undef PG8_SCHED
}
}

template <class F> struct EpiAd {
    static constexpr bool PERM = true, AFTER_DRAIN = false, MID = false;
    F f;
    __device__ __forceinline__ void operator()(const pg8::f32x4 (&acc)[2][2][4][2], const pg8::Unit& u, int wr, int wc, int fr, int fq) const {
        const int row0 = u.pm * 256 + wr * 64 + fr, col0 = u.pn * 256 + wc * 32 + 8 * fq;
#pragma unroll
        for (int ai = 0; ai < 2; ++ai)
#pragma unroll
            for (int m = 0; m < 4; ++m)
            {
                float q = 0.f;
#pragma unroll
                for (int bj = 0; bj < 2; ++bj) {
                    float v[8];
#pragma unroll
                    for (int e = 0; e < 4; ++e) { v[e] = acc[ai][bj][m][0][e]; v[4 + e] = acc[ai][bj][m][1][e]; }
                    q += f.apply(row0 + ai * 128 + m * 16, col0 + bj * 128, v);
                }
                if constexpr (F::ROWSUM) {
                    q += __shfl_xor(q, 16); q += __shfl_xor(q, 32);
                    if (fq == 0) __hip_atomic_fetch_add(f.ss + row0 + ai * 128 + m * 16, q, __ATOMIC_RELAXED, __HIP_MEMORY_SCOPE_AGENT);
                }
            }
    }
};

struct EpiMerge {
    static constexpr bool PERM = true, AFTER_DRAIN = false, MID = true;
    const bf16* proj; bf16* merged;
    __device__ __forceinline__ void mid(pg8::f32x4 (&acc)[2][2][4][2], const pg8::Unit& u) const {
        const int tid = tid_fresh(), wid = __builtin_amdgcn_readfirstlane(tid >> 6), lane = tid & 63, wr = wid >> 2, wc = wid & 3, fr = lane & 15, fq = lane >> 4;
        const int row0 = u.pm * 256 + wr * 64 + fr, col0 = u.pn * 256 + wc * 32 + 8 * fq;
#pragma unroll
        for (int ai = 0; ai < 2; ++ai) {
            u32x4 ga[4][2], gb[4][2];
#pragma unroll
            for (int m = 0; m < 4; ++m)
#pragma unroll
                for (int bj = 0; bj < 2; ++bj) {
                    const bf16* gp = proj + (size_t)(row0 + ai * 128 + m * 16) * N1 + C_GATE + col0 + bj * 128;
                    ga[m][bj] = *(const u32x4*)gp; gb[m][bj] = *(const u32x4*)(gp + DM);
                }
#pragma unroll
            for (int m = 0; m < 4; ++m)
#pragma unroll
                for (int bj = 0; bj < 2; ++bj) {
                    float a[8], b[8]; unpack8(ga[m][bj], a); unpack8(gb[m][bj], b);
#pragma unroll
                    for (int e = 0; e < 4; ++e) {
                        acc[ai][bj][m][0][e] *= b[e] * __builtin_amdgcn_rcpf(fmaxf(a[e], 1e-30f));
                        acc[ai][bj][m][1][e] *= b[4 + e] * __builtin_amdgcn_rcpf(fmaxf(a[4 + e], 1e-30f));
                    }
                }
            __builtin_amdgcn_sched_barrier(0);
        }
    }
    __device__ __forceinline__ void operator()(const pg8::f32x4 (&acc)[2][2][4][2], const pg8::Unit& u, int, int, int, int) const {
        const int tid = tid_fresh(), wid = __builtin_amdgcn_readfirstlane(tid >> 6), lane = tid & 63, wr = wid >> 2, wc = wid & 3, fr = lane & 15, fq = lane >> 4;
        const int row0 = u.pm * 256 + wr * 64 + fr, col0 = u.pn * 256 + wc * 32 + 8 * fq;
#pragma unroll
        for (int ai = 0; ai < 2; ++ai)
#pragma unroll
            for (int m = 0; m < 4; ++m)
#pragma unroll
                for (int bj = 0; bj < 2; ++bj) {
                    const int row = row0 + ai * 128 + m * 16, col = col0 + bj * 128;
                    float ga[8], v[8]; unpack8(*(const u32x4*)(proj + (size_t)row * N1 + C_GATE + col), ga);
#pragma unroll
                    for (int e = 0; e < 4; ++e) { v[e] = acc[ai][bj][m][0][e] * ga[e]; v[4 + e] = acc[ai][bj][m][1][e] * ga[4 + e]; }
                    *(u32x4*)(merged + (size_t)row * DM + col) = pack8(v);
                }
    }
};

template <class F, bool ALIGN = true>
__device__ __forceinline__ void big_gemm(LAS unsigned char* lds, const bf16* A, int lda, const bf16* Bt, int ldb, int N, int K, const F& f) {
    pg8::Gemm g{A, Bt, MP, N, K, lda, ldb}; pg8::StaticOrder S; S.init(MP, N, (int)gridDim.x, (int)blockIdx.x);
    EpiAd<F> E{f};
    pg8::gemm_phase<EpiAd<F>, pg8::StaticOrder, ALIGN, true>(lds, g, S, E);
}

template <class F>
__device__ __forceinline__ void small_gemm(LAS unsigned char* lds, const bf16* A  , int lda, const bf16* Bt, int ldb, int N, int K, const F& f) {
    const int tid = tid_fresh(), wave = tid >> 6, lane = tid & 63, fr = lane & 15, fq = lane >> 4;
    LAS float* red = (LAS float*)lds;
    const int ntask = N / 16, kw = K / 8;
    for (int task = (int)(gridDim.x - 1 - blockIdx.x); task < ntask; task += gridDim.x) {
        const int n0 = task * 16;
        f32x4 c0 = {0.f, 0.f, 0.f, 0.f}, c1 = {0.f, 0.f, 0.f, 0.f};
        const bf16* a0 = A + (size_t)fr * lda + wave * kw + fq * 8;
        const bf16* a1 = a0 + (size_t)16 * lda;
        const bf16* bp = Bt + (size_t)(n0 + fr) * ldb + wave * kw + fq * 8;
#pragma unroll 8
        for (int k = 0; k < kw; k += 32) {
            const bf16x8 av0 = *(const bf16x8*)(a0 + k), av1 = *(const bf16x8*)(a1 + k), bv = *(const bf16x8*)(bp + k);
            c0 = __builtin_amdgcn_mfma_f32_16x16x32_bf16(av0, bv, c0, 0, 0, 0);
            c1 = __builtin_amdgcn_mfma_f32_16x16x32_bf16(av1, bv, c1, 0, 0, 0);
        }
#pragma unroll
        for (int r = 0; r < 4; ++r) { red[(wave * 32 + fq * 4 + r) * 16 + fr] = c0[r]; red[(wave * 32 + 16 + fq * 4 + r) * 16 + fr] = c1[r]; }
        __syncthreads();
        if (tid < 64) {
            const int row = tid >> 1, c8 = (tid & 1) * 8;
            float v[8];
#pragma unroll
            for (int e = 0; e < 8; ++e) v[e] = 0.f;
#pragma unroll
            for (int w = 0; w < 8; ++w)
#pragma unroll
                for (int e = 0; e < 8; ++e) v[e] += red[(w * 32 + row) * 16 + c8 + e];
            const float q = f.apply(MP + row, n0 + c8, v);
            if constexpr (F::ROWSUM) __hip_atomic_fetch_add(f.ss + MP + row, q, __ATOMIC_RELAXED, __HIP_MEMORY_SCOPE_AGENT);
        }
        __syncthreads();
    }
}

template <class F>
__device__ __forceinline__ void small_gemm_dual(LAS unsigned char* lds, const bf16* A, int lda, const bf16* Bt, int ldb, int N, const F& f) {
    const int tid = tid_fresh(), wave = tid >> 6, lane = tid & 63, fr = lane & 15, fq = lane >> 4;
    LAS float* red = (LAS float*)lds;
    const int ntask = N / 16, kw = 256;
    for (int task = (int)(gridDim.x - 1 - blockIdx.x); task < ntask; task += gridDim.x) {
        const int n0 = task * 16;
        f32x4 c0 = {0.f, 0.f, 0.f, 0.f}, c1 = {0.f, 0.f, 0.f, 0.f};
        const bf16* a0 = A + (size_t)fr * lda + wave * kw + fq * 8;
        const bf16* a1 = a0 + (size_t)16 * lda;
        const bf16* bp = Bt + (size_t)(n0 + fr) * ldb + wave * kw + fq * 8;
#pragma unroll
        for (int k = 0; k < kw; k += 32) {
            const bf16x8 av0 = *(const bf16x8*)(a0 + k), av1 = *(const bf16x8*)(a1 + k), bv = *(const bf16x8*)(bp + k);
            c0 = __builtin_amdgcn_mfma_f32_16x16x32_bf16(av0, bv, c0, 0, 0, 0);
            c1 = __builtin_amdgcn_mfma_f32_16x16x32_bf16(av1, bv, c1, 0, 0, 0);
        }
#pragma unroll
        for (int r = 0; r < 4; ++r) { red[(wave * 32 + fq * 4 + r) * 16 + fr] = c0[r]; red[(wave * 32 + 16 + fq * 4 + r) * 16 + fr] = c1[r]; }
        __syncthreads();
        if (tid < 64) {
            const int row = tid >> 1, c8 = (tid & 1) * 8;
            float va[8], vb[8];
#pragma unroll
            for (int e = 0; e < 8; ++e) { va[e] = 0.f; vb[e] = 0.f; }
#pragma unroll
            for (int w = 0; w < 4; ++w)
#pragma unroll
                for (int e = 0; e < 8; ++e) { va[e] += red[(w * 32 + row) * 16 + c8 + e]; vb[e] += red[((w + 4) * 32 + row) * 16 + c8 + e]; }
            f.apply2(MP + row, n0 + c8, va, vb);
        }
        __syncthreads();
    }
}

__device__ __forceinline__ void st8f(float* o, const float (&v)[8]) { *(f32x4*)o = (f32x4){v[0], v[1], v[2], v[3]}; *(f32x4*)(o + 4) = (f32x4){v[4], v[5], v[6], v[7]}; }
__device__ __forceinline__ void ld8f(const float* o, float (&v)[8]) { const f32x4 a = *(const f32x4*)o, b = *(const f32x4*)(o + 4); v[0] = a.x; v[1] = a.y; v[2] = a.z; v[3] = a.w; v[4] = b.x; v[5] = b.y; v[6] = b.z; v[7] = b.w; }

struct E1 {
    static constexpr bool ROWSUM = false;
    bf16* proj; const float* b_gate; float* out;
    __device__ __forceinline__ float apply(int row, int col, float (&v)[8]) const {
        if (col >= C_GATE) {
            float b[8]; ld8f(b_gate + (col - C_GATE), b);
#pragma unroll
            for (int e = 0; e < 8; ++e) v[e] = sigmoidf_(v[e] + b[e]);
        } else if (col >= C_GU) {
#pragma unroll
            for (int e = 0; e < 8; ++e) v[e] = gelu_tanh(v[e]);
        } else if (col >= C_V) {
            if (row < MP) { const int t = row & (SEQ - 1); if (t >= SEQ - 128) st8f(out + OFF_VP + ((size_t)((row >> 11) * 128 + (t - (SEQ - 128)))) * 256 + (col - C_V), v); }
            else st8f(out + OFF_VS + ((size_t)((row - MP) * 128 + 127)) * 256 + (col - C_V), v);
        }
        *(u32x4*)(proj + (size_t)row * N1 + col) = pack8(v);
        return 0.f;
    }
};
struct E2s {
    const bf16* proj; bf16* merged;
    __device__ __forceinline__ void apply2(int row, int col, float (&va)[8], float (&vb)[8]) const {
        float ga[8], gb[8]; unpack8(*(const u32x4*)(proj + (size_t)row * N1 + C_GATE + col), ga); unpack8(*(const u32x4*)(proj + (size_t)row * N1 + C_GATE + DM + col), gb);
#pragma unroll
        for (int e = 0; e < 8; ++e) va[e] = gb[e] * va[e] + ga[e] * vb[e];
        *(u32x4*)(merged + (size_t)row * DM + col) = pack8(va);
    }
};
struct E3 {
    static constexpr bool ROWSUM = true;
    const float *xp, *xs; float* y; const float* nw; bf16* xn; float* ss;
    __device__ __forceinline__ float apply(int row, int col, float (&v)[8]) const {
        const float* xr = row < MP ? xp + (size_t)row * DM : xs + (size_t)(row - MP) * DM;
        float x[8], w[8]; ld8f(xr + col, x); ld8f(nw + col, w);
        float q = 0.f;
#pragma unroll
        for (int e = 0; e < 8; ++e) { v[e] += x[e]; q += v[e] * v[e]; }
        st8f(y + (size_t)row * DM + col, v);
#pragma unroll
        for (int e = 0; e < 8; ++e) v[e] *= w[e];
        *(u32x4*)(xn + (size_t)row * DM + col) = pack8(v);
        return q;
    }
};
struct E4s {
    static constexpr bool ROWSUM = false;
    float* hs; float* out; const float* ss;
    __device__ __forceinline__ float apply(int row, int col, float (&v)[8]) const {
        const float rs = rsqrtf(ss[row] * (1.f / DM) + EPS);
#pragma unroll
        for (int e = 0; e < 8; ++e) v[e] *= rs;
        const int ch = (col >> 8) * 128 + (col & 127) + ((col & 128) ? DFF : 0);
        st8f(out + OFF_CS + ((size_t)((row - MP) * 2 + 1)) * NUP + ch, v);
        st8f(hs + (size_t)(row - MP) * NUP + col, v);
        return 0.f;
    }
};
template <int CTRL> __device__ __forceinline__ unsigned dppu(unsigned old, unsigned src) { return (unsigned)__builtin_amdgcn_update_dpp((int)old, (int)src, CTRL, 0xf, 0xf, false); }
template <int CTRL> __device__ __forceinline__ float dppf(float old, float src) {
    return __builtin_bit_cast(float, __builtin_amdgcn_update_dpp(__builtin_bit_cast(int, old), __builtin_bit_cast(int, src), CTRL, 0xf, 0xf, false));
}
struct EpiConv {
    static constexpr bool PERM = true, AFTER_DRAIN = false, MID = false;
    bf16* act; float* out; const float* ss; const float* cw; const float* cb; float* hb; LAS float* xb;
    __device__ __forceinline__ void operator()(const pg8::f32x4 (&acc)[2][2][4][2], const pg8::Unit& u, int, int, int, int) const {
        const int tid = tid_fresh(), wid = __builtin_amdgcn_readfirstlane(tid >> 6), lane = tid & 63, wr = wid >> 2, wc = wid & 3, fr = lane & 15, fq = lane >> 4;
        const int rowb = u.pm * 256 + wr * 64 + fr, cl = wc * 32 + 8 * fq, chg = u.pn * 128 + cl;
#define RS_(ai_, m_) __builtin_amdgcn_rsqf(ssl[(unsigned)(rowb + (ai_) * 128 + (m_) * 16)] * (1.f / DM) + EPS)
        const float* ssl = ss; asm volatile("" : "+s"(ssl));
        if (fr >= 14) {
#pragma unroll
            for (int ai = 0; ai < 2; ++ai) { LAS float* d = xb + ((ai * 2 + wr) * 2 + (fr - 14)) * 256 + cl; const float r3 = RS_(ai, 3);
#pragma unroll
                for (int bj = 0; bj < 2; ++bj) { *(LAS f32x4*)(d + bj * 128) = acc[ai][bj][3][0] * r3; *(LAS f32x4*)(d + bj * 128 + 4) = acc[ai][bj][3][1] * r3; } }
        }
        if (wr == 0 && fr < 2) { float* d = hb + (unsigned)((u.pm * 4 + fr) * NUP + u.pn * 256 + cl); const float r0 = RS_(0, 0);
#pragma unroll
            for (int bj = 0; bj < 2; ++bj) { *(f32x4*)(d + bj * 128) = acc[0][bj][0][0] * r0; *(f32x4*)(d + bj * 128 + 4) = acc[0][bj][0][1] * r0; } }
        if (wr == 1 && fr >= 14) { float* d = hb + (unsigned)((u.pm * 4 + 2 + fr - 14) * NUP + u.pn * 256 + cl); const float r3 = RS_(1, 3);
#pragma unroll
            for (int bj = 0; bj < 2; ++bj) { *(f32x4*)(d + bj * 128) = acc[1][bj][3][0] * r3; *(f32x4*)(d + bj * 128 + 4) = acc[1][bj][3][1] * r3; } }
        {
            LAS float* wl = xb + (WL_OFF - 131072) / 4; LAS float* rsl = xb + (RSL_OFF - 131072) / 4;
            const int idx = tid * 2, k = idx >> 8, c = idx & 255;
            const int chn = (c < 128) ? u.pn * 128 + c : DFF + u.pn * 128 + (c - 128);
            const float* src = (k < 3) ? cw + (unsigned)(k * NUP + chn) : cb + (unsigned)chn;
            const f32x2_t wv = *(const f32x2_t*)src;
            *(LAS f32x2_t*)(wl + idx) = wv;
            if (tid < 256) rsl[tid] = __builtin_amdgcn_rsqf(ssl[(unsigned)(u.pm * 256 + tid)] * (1.f / DM) + EPS);
        }
        __builtin_amdgcn_sched_barrier(0);
        asm volatile("s_waitcnt lgkmcnt(0)" ::: "memory");
        __builtin_amdgcn_s_barrier();
        const LAS float* wl = xb + (WL_OFF - 131072) / 4; const LAS float* rsl = xb + (RSL_OFF - 131072) / 4 + wr * 64 + fr;
#pragma unroll
        for (int ai = 0; ai < 2; ++ai)
#pragma unroll
            for (int m = 0; m < 4; ++m) {
                const int row = rowb + ai * 128 + m * 16, t = row & (SEQ - 1);
                const float rsc = rsl[ai * 128 + m * 16], rsp = rsl[ai * 128 + (m > 0 ? m - 1 : 0) * 16];
                unsigned opk[4];
#pragma unroll
                for (int n = 0; n < 2; ++n) {
                    float o[4];
#pragma unroll
                    for (int bj = 0; bj < 2; ++bj) {
                        const int ch = chg + bj * DFF;
                        const f32x4 cur = acc[ai][bj][m][n] * rsc;
                        f32x4 xp = {0.f, 0.f, 0.f, 0.f};
                        if (m > 0) xp = acc[ai][bj][m > 0 ? m - 1 : 0][n] * rsp;
                        else if (!(ai == 0 && wr == 0) && fr >= 14)
                            xp = *(const LAS f32x4*)(xb + ((wr == 1 ? (ai * 2 + 0) : ((ai - 1) * 2 + 1)) * 2 + (fr - 14)) * 256 + bj * 128 + cl + 4 * n);
                        const unsigned c01 = pk2m(cur[0], cur[1]), c23 = pk2m(cur[2], cur[3]), x01 = pk2m(xp[0], xp[1]), x23 = pk2m(xp[2], xp[3]);
                        unsigned a01 = dppu<0x111>(dppu<0x121>(0u, x01), c01), a23 = dppu<0x111>(dppu<0x121>(0u, x23), c23);
                        unsigned b01 = dppu<0x112>(dppu<0x122>(0u, x01), c01), b23 = dppu<0x112>(dppu<0x122>(0u, x23), c23);
                        if (t < 1) { a01 = 0u; a23 = 0u; }
                        if (t < 2) { b01 = 0u; b23 = 0u; }
                        const float p1[4] = {bf_lo(a01), bf_hi(a01), bf_lo(a23), bf_hi(a23)}, p2[4] = {bf_lo(b01), bf_hi(b01), bf_lo(b23), bf_hi(b23)};
                        const LAS float* wp = wl + bj * 128 + cl + 4 * n;
                        const f32x4 w0 = *(const LAS f32x4*)wp, w1 = *(const LAS f32x4*)(wp + 256), w2 = *(const LAS f32x4*)(wp + 512), bb = *(const LAS f32x4*)(wp + 768);
                        if (t >= SEQ - 2) *(f32x4*)(out + OFF_CP + (unsigned)(((row >> 11) * 2 + (t - (SEQ - 2))) * NUP + ch + 4 * n)) = cur;
#pragma unroll
                        for (int e = 0; e < 4; ++e) {
                            const float hc = w0[e] * p2[e] + w1[e] * p1[e] + w2[e] * cur[e] + bb[e];
                            if (bj == 0) o[e] = silu_(hc); else o[e] *= hc;
                        }
                    }
                    opk[2 * n] = pk2(o[0], o[1]); opk[2 * n + 1] = pk2(o[2], o[3]);
                }
                *(u32x4*)(act + (unsigned)(row * DFF + chg)) = (u32x4){opk[0], opk[1], opk[2], opk[3]};
                __builtin_amdgcn_sched_barrier(0);
            }
#undef RS_
    }
};
struct E5 {
    static constexpr bool ROWSUM = true;
    float* y; const float* nw; bf16* xn; float* ss;
    __device__ __forceinline__ float apply(int row, int col, float (&v)[8]) const {
        float x[8], w[8]; ld8f(y + (size_t)row * DM + col, x); ld8f(nw + col, w);
        float q = 0.f;
#pragma unroll
        for (int e = 0; e < 8; ++e) { v[e] += x[e]; q += v[e] * v[e]; }
        st8f(y + (size_t)row * DM + col, v);
#pragma unroll
        for (int e = 0; e < 8; ++e) v[e] *= w[e];
        *(u32x4*)(xn + (size_t)row * DM + col) = pack8(v);
        return q;
    }
};
struct E6a {
    static constexpr bool ROWSUM = false;
    bf16* pp;
    __device__ __forceinline__ float apply(int row, int col, float (&v)[8]) const { *(u32x4*)(pp + (size_t)row * DM + col) = pack8(v); return 0.f; }
};
struct E6b {
    static constexpr bool ROWSUM = false;
    const bf16* pp; float* y; const float* ss;
    __device__ __forceinline__ float apply(int row, int col, float (&v)[8]) const {
        const float rs = rsqrtf(ss[row] * (1.f / DM) + EPS);
        float x[8], q[8]; ld8f(y + (size_t)row * DM + col, x); unpack8(*(const u32x4*)(pp + (size_t)row * DM + col), q);
#pragma unroll
        for (int e = 0; e < 8; ++e) v[e] = x[e] + sigmoidf_(v[e] * rs) * q[e];
        st8f(y + (size_t)row * DM + col, v);
        return 0.f;
    }
};

struct TItem { const float* src; bf16* dst; int N, ldk; };
constexpr int I_IN = 32 * 112, I_GATE = 32 * 128, I_BA = 16 * 64, I_BG = 16 * 64, I_OUT = 32 * 64, I_UP = 32 * 352, I_DOWN = 88 * 64, I_PG = 32 * 64, I_PP = 4 * 64;
constexpr int NITEMS = I_IN + I_GATE + I_BA + I_BG + I_OUT + I_UP + I_DOWN + I_PG + I_PP, I_EARLY = I_IN + I_GATE + I_PP, I_MID = I_EARLY + I_BA + I_BG + I_OUT;
__device__ __forceinline__ TItem titem_mk(const float* W, int N, bf16* WT, int ldk, int item, bool upperm) {
    const int nblk = N / 32, kb = item / nblk, nb = item - kb * nblk, k0 = 64 * kb, n0 = 32 * nb;
    const int r0 = !upperm ? n0 : (n0 < DFF ? (n0 >> 7) * 256 + (n0 & 127) : ((n0 - DFF) >> 7) * 256 + 128 + ((n0 - DFF) & 127));
    TItem t; t.src = W + (size_t)k0 * N + n0; t.dst = WT + (size_t)r0 * ldk + k0; t.N = N; t.ldk = ldk; return t;
}
__device__ __forceinline__ TItem titem(KP p, int it) {
    unsigned char* ws = p->ws; int r = it;
    if (r < I_IN) return titem_mk(p->w_in, 3584, (bf16*)(ws + WS_W1), 2048, r, false); r -= I_IN;
    if (r < I_GATE) return titem_mk(p->w_gate, 4096, (bf16*)(ws + WS_W1) + (size_t)C_GATE * 2048, 2048, r, false); r -= I_GATE;
    if (r < I_PP) return titem_mk(p->w_ple_proj, 2048, (bf16*)(ws + WS_WPP), PLE, r, false); r -= I_PP;
    if (r < I_BA) return titem_mk(p->w_br_attn, 2048, (bf16*)(ws + WS_WBA), 2048, r, false); r -= I_BA;
    if (r < I_BG) return titem_mk(p->w_br_gm, 2048, (bf16*)(ws + WS_WBA) + 1024, 2048, r, false); r -= I_BG;
    if (r < I_OUT) return titem_mk(p->w_out, 2048, (bf16*)(ws + WS_WOUT), 2048, r, false); r -= I_OUT;
    if (r < I_UP) return titem_mk(p->w_up, NUP, (bf16*)(ws + WS_WUP), 2048, r, true); r -= I_UP;
    if (r < I_DOWN) return titem_mk(p->w_down, 2048, (bf16*)(ws + WS_WDOWN), DFF, r, false); r -= I_DOWN;
    return titem_mk(p->w_ple_gate, 2048, (bf16*)(ws + WS_WPG), 2048, r, false);
}
__device__ __forceinline__ void tload(const TItem& s, f32x4 (&t)[8], int lane) {
#pragma unroll
    for (int j = 0; j < 8; ++j) t[j] = *(const f32x4*)(s.src + (size_t)((lane >> 3) + 8 * j) * s.N + (lane & 7) * 4);
}
__device__ __forceinline__ void tstore(const TItem& s, const f32x4 (&t)[8], LAS float* scr, int lane) {
#pragma unroll
    for (int j = 0; j < 8; ++j) { LAS float* d = scr + ((lane >> 3) + 8 * j) * 33 + (lane & 7) * 4; d[0] = t[j].x; d[1] = t[j].y; d[2] = t[j].z; d[3] = t[j].w; }
    asm volatile("s_waitcnt lgkmcnt(0)" ::: "memory");
    const int c = lane & 7;
#pragma unroll
    for (int j = 0; j < 4; ++j) { const int n = (lane >> 3) + 8 * j; const LAS float* q = scr + (8 * c) * 33 + n;
        u32x4 o; o.x = pk2(q[0 * 33], q[1 * 33]); o.y = pk2(q[2 * 33], q[3 * 33]); o.z = pk2(q[4 * 33], q[5 * 33]); o.w = pk2(q[6 * 33], q[7 * 33]);
        *(u32x4*)(s.dst + (size_t)n * s.ldk + 8 * c) = o; }
    asm volatile("s_waitcnt lgkmcnt(0)" ::: "memory");
}
__device__ __forceinline__ void convert_items(LAS unsigned char* lds, KP p, int lo, int hi, int w, int NW, int wave, int lane) {
    LAS float* scr = (LAS float*)(lds + wave * 16384);
    int it = lo + w; if (it >= hi) return;
    TItem cur = titem(p, it); f32x4 t[8]; tload(cur, t, lane);
    for (;;) {
        const int nx = it + NW; const bool has = nx < hi;
        TItem nxt = cur; f32x4 tn[8];
#pragma unroll
        for (int j = 0; j < 8; ++j) tn[j] = t[j];
        if (has) { nxt = titem(p, nx); tload(nxt, tn, lane); }
        tstore(cur, t, scr, lane);
        if (!has) break;
        cur = nxt; it = nx;
#pragma unroll
        for (int j = 0; j < 8; ++j) t[j] = tn[j];
    }
}
__device__ __forceinline__ void rms_row(const float* xrow, const float* w, bf16* orow, int lane) {
    f32x4 v[8]; float s = 0.f;
#pragma unroll
    for (int j = 0; j < 8; ++j) { v[j] = *(const f32x4*)(xrow + lane * 4 + 256 * j); s += (v[j].x * v[j].x + v[j].y * v[j].y) + (v[j].z * v[j].z + v[j].w * v[j].w); }
    const float rs = rsqrtf(wave_sum(s) * (1.f / DM) + EPS);
#pragma unroll
    for (int j = 0; j < 8; ++j) { const f32x4 ww = *(const f32x4*)(w + lane * 4 + 256 * j);
        u32x2 o; o.x = pk2(v[j].x * rs * ww.x, v[j].y * rs * ww.y); o.y = pk2(v[j].z * rs * ww.z, v[j].w * rs * ww.w);
        *(u32x2*)(orow + lane * 4 + 256 * j) = o; }
}
__device__ __forceinline__ void rms_phase(const float* src  , const float* w, bf16* dst) {
    const int tid = tid_fresh(), lane = tid & 63, gw = blockIdx.x * 8 + (tid >> 6), NGW = gridDim.x * 8;
    for (int m = gw; m < MALL; m += NGW) rms_row(src + (size_t)m * DM, w, dst + (size_t)m * DM, lane);
}

__device__ __forceinline__ void p0_phase(LAS unsigned char* lds, KP p) {
    const int tid = tid_fresh(), lane = tid & 63, wave = tid >> 6, gw = blockIdx.x * 8 + wave, NGW = gridDim.x * 8;
    unsigned char* ws = p->ws;
    convert_items(lds, p, 0, I_EARLY, blockIdx.x * 8 + __builtin_amdgcn_readfirstlane(wave), NGW, wave, lane);
    for (int i = blockIdx.x * 512 + tid; i < 32768; i += gridDim.x * 512) ((float*)ws)[i] = 0.f;
    bf16* XN = (bf16*)(ws + WS_XN); bf16* PBF = (bf16*)(ws + WS_PBF);
    for (int m = gw; m < MALL; m += NGW) {
        const float* xr = m < MP ? p->x_prompt + (size_t)m * DM : p->x_sample + (size_t)(m - MP) * DM;
        rms_row(xr, p->attn_norm_w, XN + (size_t)m * DM, lane);
        const float* pr = m < MP ? p->p_prompt + (size_t)m * PLE : p->p_sample + (size_t)(m - MP) * PLE;
        const f32x4 pv = *(const f32x4*)(pr + lane * 4);
        u32x2 o; o.x = pk2(pv.x, pv.y); o.y = pk2(pv.z, pv.w);
        *(u32x2*)(PBF + (size_t)m * PLE + lane * 4) = o;
    }
}

__device__ __forceinline__ void attn_prompt_unit(LAS unsigned char* lds, KP p, const bf16* proj, bf16* mix, int unit) {
    const int tid = tid_fresh(), wave = tid >> 6, lane = tid & 63, fr = lane & 15, fq = lane >> 4;
    const int kh = unit & 3, c = (unit >> 2) & 15, b = unit >> 6;
    LAS bf16* Ks = (LAS bf16*)lds;
    LAS bf16* Vt = (LAS bf16*)(lds + 36864);
#pragma unroll
    for (int i = 0; i < 4; ++i) {
        const int id = tid + 512 * i, j = id >> 3, ch = id & 7;
        const int pos = 128 * (c - 1) + j;
        u32x4 kraw = {0u, 0u, 0u, 0u}, vraw = {0u, 0u, 0u, 0u};
        if (pos >= 0) { const bf16* rp = proj + (size_t)(b * SEQ + pos) * N1; kraw = *(const u32x4*)(rp + C_K + kh * 64 + ch * 8); vraw = *(const u32x4*)(rp + C_V + kh * 64 + ch * 8); }
        float kf[8]; unpack8(kraw, kf);
        float ss = 0.f;
#pragma unroll
        for (int e = 0; e < 8; ++e) ss += kf[e] * kf[e];
        ss += __shfl_xor(ss, 1); ss += __shfl_xor(ss, 2); ss += __shfl_xor(ss, 4);
        const float rs = rsqrtf(ss * (1.f / 64.f) + EPS);
        float kw[8]; ld8f(p->k_norm_w + ch * 8, kw);
#pragma unroll
        for (int e = 0; e < 8; ++e) kf[e] = kf[e] * rs * kw[e];
        if (pos >= SEQ - 128) st8f(p->out + OFF_KP + ((size_t)((b * 128 + pos - (SEQ - 128)) * 4 + kh)) * 64 + ch * 8, kf);
        *(LAS u32x4*)(Ks + j * 72 + ch * 8) = pack8(kf);
        const unsigned vw[4] = {vraw.x, vraw.y, vraw.z, vraw.w};
#pragma unroll
        for (int e = 0; e < 8; ++e) Vt[(ch * 8 + e) * 264 + j] = (bf16)((e & 1) ? (vw[e >> 1] >> 16) : (vw[e >> 1] & 0xffffu));
    }
    __syncthreads();
    const int h = kh * 4 + (wave >> 1);
    const float slope = exp2f(-0.5f * (float)(h + 1)), sink = p->sinks[h];
    float qw0[8], qw1[8]; ld8f(p->q_norm_w + fq * 8, qw0); ld8f(p->q_norm_w + 32 + fq * 8, qw1);
    u32x4 qn0, qn1;
    { const bf16* qp = proj + (size_t)(b * SEQ + c * 128 + (wave & 1) * 64 + fr) * N1 + h * 64 + fq * 8; qn0 = *(const u32x4*)qp; qn1 = *(const u32x4*)(qp + 32); }
    for (int it = 0; it < 4; ++it) {
        int oz = 0; asm volatile("" : "+v"(oz));
        const LAS bf16* Ksi = Ks + oz; const LAS bf16* Vti = Vt + oz;
        const int qi = (wave & 1) * 64 + it * 16 + fr;
        const size_t qrow = (size_t)(b * SEQ + c * 128 + qi);
        float q0[8], q1[8]; unpack8(qn0, q0); unpack8(qn1, q1);
        { const int itn = it < 3 ? it + 1 : 3;
          const bf16* qp = proj + (size_t)(b * SEQ + c * 128 + (wave & 1) * 64 + itn * 16 + fr) * N1 + h * 64 + fq * 8; qn0 = *(const u32x4*)qp; qn1 = *(const u32x4*)(qp + 32); }
        float ss = 0.f;
#pragma unroll
        for (int e = 0; e < 8; ++e) ss += q0[e] * q0[e] + q1[e] * q1[e];
        ss += __shfl_xor(ss, 16); ss += __shfl_xor(ss, 32);
        const float rs = rsqrtf(ss * (1.f / 64.f) + EPS) * 0.125f;
#pragma unroll
        for (int e = 0; e < 8; ++e) { q0[e] = q0[e] * rs * qw0[e]; q1[e] = q1[e] * rs * qw1[e]; }
        const bf16x8 qb0 = __builtin_bit_cast(bf16x8, pack8m(q0)), qb1 = __builtin_bit_cast(bf16x8, pack8m(q1));
        f32x4 S[16];
#pragma unroll
        for (int T = 0; T < 16; ++T) {
            S[T] = (f32x4){0.f, 0.f, 0.f, 0.f};
            const LAS bf16* kp = Ksi + (T * 16 + fr) * 72 + fq * 8;
            S[T] = __builtin_amdgcn_mfma_f32_16x16x32_bf16(*(const LAS bf16x8*)kp, qb0, S[T], 0, 0, 0);
            S[T] = __builtin_amdgcn_mfma_f32_16x16x32_bf16(*(const LAS bf16x8*)(kp + 32), qb1, S[T], 0, 0, 0);
        }
        float mx = sink;
#pragma unroll
        for (int T = 0; T < 16; ++T)
#pragma unroll
            for (int r = 0; r < 4; ++r) {
                const int j = T * 16 + fq * 4 + r, dist = 128 + qi - j;
                const bool valid = (dist >= 0) && (dist <= 128) && (c > 0 || j >= 128);
                const float s = valid ? S[T][r] - slope * (float)dist : -1e30f;
                S[T][r] = s; mx = fmaxf(mx, s);
            }
        mx = fmaxf(mx, __shfl_xor(mx, 16)); mx = fmaxf(mx, __shfl_xor(mx, 32));
        float sum = 0.f;
#pragma unroll
        for (int T = 0; T < 16; ++T)
#pragma unroll
            for (int r = 0; r < 4; ++r) { const float pv = __expf(S[T][r] - mx); S[T][r] = pv; sum += pv; }
        sum += __shfl_xor(sum, 16); sum += __shfl_xor(sum, 32);
        sum += __expf(sink - mx);
        f32x4 O[4];
#pragma unroll
        for (int dt = 0; dt < 4; ++dt) O[dt] = (f32x4){0.f, 0.f, 0.f, 0.f};
#pragma unroll
        for (int s = 0; s < 8; ++s) {
            u32x4 pw; pw.x = pk2m(S[2 * s][0], S[2 * s][1]); pw.y = pk2m(S[2 * s][2], S[2 * s][3]); pw.z = pk2m(S[2 * s + 1][0], S[2 * s + 1][1]); pw.w = pk2m(S[2 * s + 1][2], S[2 * s + 1][3]);
            const bf16x8 pb = __builtin_bit_cast(bf16x8, pw);
#pragma unroll
            for (int dt = 0; dt < 4; ++dt) {
                const LAS bf16* vp = Vti + (dt * 16 + fr) * 264 + s * 32 + fq * 4;
                const u32x2 lo = *(const LAS u32x2*)vp, hi = *(const LAS u32x2*)(vp + 16);
                u32x4 vv; vv.x = lo.x; vv.y = lo.y; vv.z = hi.x; vv.w = hi.y;
                O[dt] = __builtin_amdgcn_mfma_f32_16x16x32_bf16(__builtin_bit_cast(bf16x8, vv), pb, O[dt], 0, 0, 0);
            }
        }
        const float inv = 1.f / sum;
#pragma unroll
        for (int dt = 0; dt < 4; ++dt) { u32x2 o; o.x = pk2(O[dt][0] * inv, O[dt][1] * inv); o.y = pk2(O[dt][2] * inv, O[dt][3] * inv);
            *(u32x2*)(mix + qrow * DM + h * 64 + dt * 16 + fq * 4) = o; }
    }
    __syncthreads();
}

__device__ __forceinline__ void sgu_prompt_unit(LAS unsigned char* lds, KP p, const bf16* proj, bf16* mix, int unit) {
    const int tid = tid_fresh(), wave = tid >> 6, lane = tid & 63, fr = lane & 15, fq = lane >> 4;
    const int g = unit & 3, c = (unit >> 2) & 15, b = unit >> 6;
    LAS bf16* vnT = (LAS bf16*)lds;
    LAS bf16* Wl = (LAS bf16*)(lds + 69632);
#pragma unroll
    for (int i = 0; i < 8; ++i) {
        const int id = tid + 512 * i, t = id >> 5, s4 = (id & 31) * 4;
        const f32x4 w = *(const f32x4*)(p->sgu_w + (size_t)(g * 128 + t) * 128 + s4);
        u32x2 o; o.x = pk2(s4 <= t ? w.x : 0.f, s4 + 1 <= t ? w.y : 0.f); o.y = pk2(s4 + 2 <= t ? w.z : 0.f, s4 + 3 <= t ? w.w : 0.f);
        *(LAS u32x2*)(Wl + t * 136 + s4) = o;
    }
    float nw[16];
    { float a[8], bq[8]; ld8f(p->sgu_norm_w + lane * 16, a); ld8f(p->sgu_norm_w + lane * 16 + 8, bq);
#pragma unroll
      for (int e = 0; e < 8; ++e) { nw[e] = a[e]; nw[8 + e] = bq[e]; } }
    for (int r8 = 0; r8 < 16; r8 += 8) {
        const int s0 = wave * 16 + r8;
        float x[8][16];
#pragma unroll
        for (int q = 0; q < 8; ++q) {
            const bf16* gp = proj + (size_t)(b * SEQ + c * 128 + s0 + q) * N1 + C_GV + lane * 16;
            const u32x4 ua = *(const u32x4*)gp, ub = *(const u32x4*)(gp + 8);
            float a[8], bq[8]; unpack8(ua, a); unpack8(ub, bq);
#pragma unroll
            for (int e = 0; e < 8; ++e) { x[q][e] = a[e]; x[q][8 + e] = bq[e]; }
        }
        float mean[8], rstd[8];
#pragma unroll
        for (int q = 0; q < 8; ++q) { float sm = 0.f;
#pragma unroll
            for (int e = 0; e < 16; ++e) sm += x[q][e];
            mean[q] = wave_sum(sm) * (1.f / 1024.f); }
#pragma unroll
        for (int q = 0; q < 8; ++q) { float sq = 0.f;
#pragma unroll
            for (int e = 0; e < 16; ++e) { x[q][e] -= mean[q]; sq += x[q][e] * x[q][e]; }
            rstd[q] = rsqrtf(wave_sum(sq) * (1.f / 1024.f) + EPS); }
        if (fq == g) {
#pragma unroll
            for (int q = 0; q < 8; ++q) {
#pragma unroll
                for (int e = 0; e < 16; ++e) x[q][e] = x[q][e] * rstd[q] * nw[e];
                if (c == 15) { float* o = p->out + OFF_GP + ((size_t)(b * 128 + s0 + q)) * 1024 + lane * 16;
#pragma unroll
                    for (int e4 = 0; e4 < 4; ++e4) *(f32x4*)(o + 4 * e4) = (f32x4){x[q][4 * e4], x[q][4 * e4 + 1], x[q][4 * e4 + 2], x[q][4 * e4 + 3]}; }
            }
#pragma unroll
            for (int e = 0; e < 16; ++e) {
                u32x4 w; w.x = pk2(x[0][e], x[1][e]); w.y = pk2(x[2][e], x[3][e]); w.z = pk2(x[4][e], x[5][e]); w.w = pk2(x[6][e], x[7][e]);
                *(LAS u32x4*)(vnT + (fr * 16 + e) * 136 + s0) = w;
            }
        }
    }
    __syncthreads();
    f32x4 acc[8][2];
#pragma unroll
    for (int tt = 0; tt < 8; ++tt) { acc[tt][0] = (f32x4){0.f, 0.f, 0.f, 0.f}; acc[tt][1] = (f32x4){0.f, 0.f, 0.f, 0.f}; }
#pragma unroll
    for (int ks = 0; ks < 4; ++ks) {
        const bf16x8 a0 = *(const LAS bf16x8*)(vnT + (wave * 32 + fr) * 136 + ks * 32 + fq * 8);
        const bf16x8 a1 = *(const LAS bf16x8*)(vnT + (wave * 32 + 16 + fr) * 136 + ks * 32 + fq * 8);
#pragma unroll
        for (int tt = 2 * ks; tt < 8; ++tt) {
            const bf16x8 bw = *(const LAS bf16x8*)(Wl + (tt * 16 + fr) * 136 + ks * 32 + fq * 8);
            acc[tt][0] = __builtin_amdgcn_mfma_f32_16x16x32_bf16(a0, bw, acc[tt][0], 0, 0, 0);
            acc[tt][1] = __builtin_amdgcn_mfma_f32_16x16x32_bf16(a1, bw, acc[tt][1], 0, 0, 0);
        }
    }
#pragma unroll
    for (int tt = 0; tt < 8; ++tt) {
        const int t = tt * 16 + fr; const size_t row = (size_t)(b * SEQ + c * 128 + t);
        const float bias = p->sgu_b[g * 128 + t];
#pragma unroll
        for (int ct = 0; ct < 2; ++ct) {
            const int ch = g * 256 + wave * 32 + ct * 16 + fq * 4;
            const u32x2 gu = *(const u32x2*)(proj + row * N1 + C_GU + ch);
            u32x2 o; o.x = pk2((acc[tt][ct][0] + bias) * bf_lo(gu.x), (acc[tt][ct][1] + bias) * bf_hi(gu.x));
            o.y = pk2((acc[tt][ct][2] + bias) * bf_lo(gu.y), (acc[tt][ct][3] + bias) * bf_hi(gu.y));
            *(u32x2*)(mix + row * DM + 1024 + ch) = o;
        }
    }
    __syncthreads();
}

__device__ __forceinline__ void sample_attn_item(LAS float* wl  , KP p, const bf16* proj, bf16* mix, int item, int lane) {
    const int h = item & 15, b = item >> 4, kh = h >> 2;
    const bf16* rp = proj + (size_t)(MP + b) * N1;
    float q = bf_lo((unsigned)rp[h * 64 + lane]), kn = bf_lo((unsigned)rp[C_K + kh * 64 + lane]), vn = bf_lo((unsigned)rp[C_V + kh * 64 + lane]);
    q = q * rsqrtf(wave_sum(q * q) * (1.f / 64.f) + EPS) * p->q_norm_w[lane] * 0.125f;
    kn = kn * rsqrtf(wave_sum(kn * kn) * (1.f / 64.f) + EPS) * p->k_norm_w[lane];
    const float slope = exp2f(-0.5f * (float)(h + 1)), sink = p->sinks[h];
    wl[lane] = q;
    asm volatile("s_waitcnt lgkmcnt(0)" ::: "memory");
    const float* kb = p->st_k + ((size_t)b * 128 * 4 + kh) * 64;
    float s0 = 0.f, s1 = 0.f;
    { const float* k0 = kb + (size_t)lane * 256; const float* k1 = kb + (size_t)(lane + 64) * 256;
#pragma unroll
      for (int d = 0; d < 64; d += 4) { const f32x4 a = *(const f32x4*)(k0 + d), c4 = *(const f32x4*)(k1 + d);
          const float w0 = wl[d], w1 = wl[d + 1], w2 = wl[d + 2], w3 = wl[d + 3];
          s0 += a.x * w0 + a.y * w1 + a.z * w2 + a.w * w3; s1 += c4.x * w0 + c4.y * w1 + c4.z * w2 + c4.w * w3; } }
    const float* vb = p->st_v + ((size_t)b * 128 * 4 + kh) * 64 + lane;
    float vv[128];
#pragma unroll
    for (int j = 0; j < 128; ++j) vv[j] = vb[(size_t)j * 256];
    s0 -= slope * (float)(128 - lane); s1 -= slope * (float)(64 - lane);
    const float sn = wave_sum(q * kn);
    const float mx = fmaxf(fmaxf(wave_max(fmaxf(s0, s1)), sn), sink);
    const float p0 = __expf(s0 - mx), p1 = __expf(s1 - mx), pn = __expf(sn - mx);
    const float den = wave_sum(p0 + p1) + pn + __expf(sink - mx);
    wl[64 + lane] = p0; wl[128 + lane] = p1;
    asm volatile("s_waitcnt lgkmcnt(0)" ::: "memory");
    float o = pn * vn;
#pragma unroll
    for (int j = 0; j < 128; ++j) o += wl[64 + j] * vv[j];
    mix[(size_t)(MP + b) * DM + h * 64 + lane] = (bf16)(pk2(o / den, 0.f) & 0xffffu);
    if ((h & 3) == 0) p->out[OFF_KS + ((size_t)(b * 128 + 127) * 4 + kh) * 64 + lane] = kn;
    asm volatile("s_waitcnt lgkmcnt(0)" ::: "memory");
}
__device__ __forceinline__ void sample_sgu_item(KP p, const bf16* proj, bf16* mix, int b, int lane) {
    const bf16* rp = proj + (size_t)(MP + b) * N1;
    float x[16];
    { float a[8], bq[8]; unpack8(*(const u32x4*)(rp + C_GV + lane * 16), a); unpack8(*(const u32x4*)(rp + C_GV + lane * 16 + 8), bq);
#pragma unroll
      for (int e = 0; e < 8; ++e) { x[e] = a[e]; x[8 + e] = bq[e]; } }
    float sm = 0.f;
#pragma unroll
    for (int e = 0; e < 16; ++e) sm += x[e];
    const float mean = wave_sum(sm) * (1.f / 1024.f);
    float sq = 0.f;
#pragma unroll
    for (int e = 0; e < 16; ++e) { x[e] -= mean; sq += x[e] * x[e]; }
    const float rstd = rsqrtf(wave_sum(sq) * (1.f / 1024.f) + EPS);
    const int g = lane >> 4;
    const float w00 = p->sgu_w[(size_t)g * 128 * 128], b0 = p->sgu_b[g * 128];
    float gu[16];
    { float a[8], bq[8]; unpack8(*(const u32x4*)(rp + C_GU + lane * 16), a); unpack8(*(const u32x4*)(rp + C_GU + lane * 16 + 8), bq);
#pragma unroll
      for (int e = 0; e < 8; ++e) { gu[e] = a[e]; gu[8 + e] = bq[e]; } }
    float o8[8], o9[8];
#pragma unroll
    for (int e = 0; e < 16; ++e) {
        const float vn = x[e] * rstd * p->sgu_norm_w[lane * 16 + e];
        p->out[OFF_GS + (size_t)b * 1024 + lane * 16 + e] = vn;
        const float r = gu[e] * (w00 * vn + b0);
        if (e < 8) o8[e] = r; else o9[e - 8] = r;
    }
    *(u32x4*)(mix + (size_t)(MP + b) * DM + 1024 + lane * 16) = pack8(o8);
    *(u32x4*)(mix + (size_t)(MP + b) * DM + 1024 + lane * 16 + 8) = pack8(o9);
}

__device__ __forceinline__ void p2_phase(LAS unsigned char* lds, KP p, const bf16* proj, bf16* mix) {
    const int G = gridDim.x;
    for (int u = blockIdx.x; u < 256; u += G) attn_prompt_unit(lds, p, proj, mix, u);
    for (int u = blockIdx.x; u < 256; u += G) sgu_prompt_unit(lds, p, proj, mix, u);
    const int tid = tid_fresh(), lane = tid & 63, wave = tid >> 6, gw = blockIdx.x * 8 + wave, NGW = G * 8;
    LAS float* wl = (LAS float*)lds + wave * 256;
    for (int it = gw; it < 512 + 32; it += NGW) {
        if (it < 512) sample_attn_item(wl, p, proj, mix, it, lane);
        else sample_sgu_item(p, proj, mix, it - 512, lane);
    }
    for (int idx = blockIdx.x * 512 + tid; idx < MS * 127 * 64; idx += G * 512) {
        const int bb = idx / (127 * 64), rem = idx - bb * (127 * 64), j = rem >> 6, c4 = (rem & 63) * 4;
        const size_t src = ((size_t)(bb * 128 + j + 1)) * 256 + c4, dst = ((size_t)(bb * 128 + j)) * 256 + c4;
        *(f32x4*)(p->out + OFF_KS + dst) = *(const f32x4*)(p->st_k + src);
        *(f32x4*)(p->out + OFF_VS + dst) = *(const f32x4*)(p->st_v + src);
    }
    __syncthreads();
    {
        constexpr int FIRST = (512 + MS + 7) / 8;
        const int f = ((int)gridDim.x > 2 * FIRST) ? FIRST : 0;
        if ((int)blockIdx.x >= f) convert_items(lds, p, I_EARLY, I_MID, ((int)blockIdx.x - f) * 8 + __builtin_amdgcn_readfirstlane(wave), ((int)gridDim.x - f) * 8, __builtin_amdgcn_readfirstlane(wave), lane);
    }
    __syncthreads();
}

__device__ __forceinline__ void conv_fix_phase(KP p, const float* hb, const float* hs, bf16* act) {
    const int NT = gridDim.x * 512;
    constexpr int NCG = DFF / 8, NPR = 28 * 2;
    for (int it = blockIdx.x * 512 + tid_fresh(); it < NCG * (NPR + MS); it += NT) {
        const int cgp = it % NCG, ri = it / NCG, ch = cgp * 8, colg = (ch >> 7) * 256 + (ch & 127), colu = colg + 128;
        float wg0[8], wg1[8], wg2[8], bg[8], wu0[8], wu1[8], wu2[8], bu[8];
        ld8f(p->conv_w + ch, wg0); ld8f(p->conv_w + NUP + ch, wg1); ld8f(p->conv_w + 2 * NUP + ch, wg2); ld8f(p->conv_b + ch, bg);
        ld8f(p->conv_w + DFF + ch, wu0); ld8f(p->conv_w + NUP + DFF + ch, wu1); ld8f(p->conv_w + 2 * NUP + DFF + ch, wu2); ld8f(p->conv_b + DFF + ch, bu);
        float g2[8], g1[8], g0[8], u2[8], u1[8], u0[8], o[8];
        size_t orow;
        if (ri < NPR) {
            const int k = ri >> 1, rr = ri & 1, pm = (k / 7) * 8 + (k % 7) + 1;
            const float* h2 = rr == 0 ? hb + ((size_t)((pm - 1) * 4 + 2)) * NUP : hb + ((size_t)((pm - 1) * 4 + 3)) * NUP;
            const float* h1 = rr == 0 ? hb + ((size_t)((pm - 1) * 4 + 3)) * NUP : hb + ((size_t)(pm * 4 + 0)) * NUP;
            const float* h0 = hb + ((size_t)(pm * 4 + rr)) * NUP;
            ld8f(h2 + colg, g2); ld8f(h1 + colg, g1); ld8f(h0 + colg, g0); ld8f(h2 + colu, u2); ld8f(h1 + colu, u1); ld8f(h0 + colu, u0);
            orow = (size_t)pm * 256 + rr;
        } else {
            const int bb = ri - NPR;
            const float* st = p->st_conv + (size_t)bb * 2 * NUP;
            ld8f(st + ch, g2); ld8f(st + NUP + ch, g1); ld8f(st + DFF + ch, u2); ld8f(st + NUP + DFF + ch, u1);
            ld8f(hs + (size_t)bb * NUP + colg, g0); ld8f(hs + (size_t)bb * NUP + colu, u0);
            st8f(p->out + OFF_CS + (size_t)bb * 2 * NUP + ch, g1); st8f(p->out + OFF_CS + (size_t)bb * 2 * NUP + DFF + ch, u1);
            orow = (size_t)MP + bb;
        }
#pragma unroll
        for (int e = 0; e < 8; ++e) {
            const float hg = wg0[e] * g2[e] + wg1[e] * g1[e] + wg2[e] * g0[e] + bg[e];
            const float hu = wu0[e] * u2[e] + wu1[e] * u1[e] + wu2[e] * u0[e] + bu[e];
            o[e] = silu_(hg) * hu;
        }
        *(u32x4*)(act + orow * DFF + ch) = pack8(o);
    }
}

__device__ __forceinline__ void bubble_convert(LAS unsigned char* lds, KP p, int first, int lo, int hi) {
    if ((int)blockIdx.x < first) return;
    const int tid = tid_fresh(), lane = tid & 63, wave = __builtin_amdgcn_readfirstlane(tid >> 6);
    convert_items(lds, p, lo, hi, ((int)blockIdx.x - first) * 8 + wave, ((int)gridDim.x - first) * 8, wave, lane);
    __syncthreads();
}
__device__ __forceinline__ void lower_half_convert(LAS unsigned char* lds, KP p, int lo, int hi) {
    const int half = (int)gridDim.x / 2;
    if ((int)blockIdx.x >= half) return;
    const int tid = tid_fresh(), lane = tid & 63, wave = __builtin_amdgcn_readfirstlane(tid >> 6);
    convert_items(lds, p, lo, hi, (int)blockIdx.x * 8 + wave, half * 8, wave, lane);
    __syncthreads();
}
#define XB_TMO      128
#define XB_XCNT(j)  (256  + 64 * (j))
#define XB_XSUB(j)  (1280 + 64 * (j))
#define XB_XGEN(j)  (2304 + 64 * (j))
#define XB_TOP      3328
#define XB_TOPGEN   3392
#define XCD_BAR_WORDS 3456
#define XB_SPIN_CAP (1u << 18)

__device__ __forceinline__ unsigned xb_ld(unsigned* p)              { return __hip_atomic_load(p, __ATOMIC_RELAXED, __HIP_MEMORY_SCOPE_AGENT); }
__device__ __forceinline__ unsigned xb_add(unsigned* p, unsigned v) { return __hip_atomic_fetch_add(p, v, __ATOMIC_RELAXED, __HIP_MEMORY_SCOPE_AGENT); }
__device__ __forceinline__ unsigned xb_xcc_id() { return (unsigned)__builtin_amdgcn_s_getreg((3 << 11) | 20) & 0xFu; }
#define XB_SPIN(cond, bar) do { unsigned _sp = 0; while (cond) { __builtin_amdgcn_s_sleep(1); \
    if ((++_sp & 255u) == 0u) { if (xb_ld(&(bar)[XB_TMO])) break; if (_sp > XB_SPIN_CAP) { atomicAdd(&(bar)[XB_TMO], 1u); break; } } } } while (0)

struct XcdBarrier {
    unsigned* bar; unsigned x;
    volatile LAS unsigned* st;
};

__device__ __forceinline__ XcdBarrier xcd_barrier_post(unsigned* bar, volatile LAS unsigned* st) {
    XcdBarrier b; b.bar = bar; b.x = xb_xcc_id(); b.st = st;
    if (threadIdx.x == 0) (void)xb_add(&bar[XB_XCNT(b.x)], 1u);
    return b;
}
__device__ __forceinline__ void xcd_barrier_complete(unsigned* bar, unsigned x, unsigned& nloc, unsigned& nx) {
    const unsigned G = gridDim.x * gridDim.y * gridDim.z;
    unsigned sum, cnt, mine, sp = 0u;
    for (;;) {
        sum = 0u; cnt = 0u; mine = 0u;
#pragma unroll
        for (unsigned j = 0; j < 16; ++j) { const unsigned c = xb_ld(&bar[XB_XCNT(j)]); sum += c; cnt += (c > 0u) ? 1u : 0u; mine = (j == x) ? c : mine; }
        if (sum == G) break;
        __builtin_amdgcn_s_sleep(1);
        if ((++sp & 255u) == 0u) { if (xb_ld(&bar[XB_TMO])) break; if (sp > XB_SPIN_CAP) { atomicAdd(&bar[XB_TMO], 1u); break; } }
    }
    nloc = mine > 0u ? mine : 1u; nx = cnt > 0u ? cnt : 1u;
}

__device__ __forceinline__ void xcd_barrier(const XcdBarrier& b) {
    asm volatile("s_waitcnt vmcnt(0)" ::: "memory");
    __syncthreads();
    if (threadIdx.x == 0) {
        unsigned* bar = b.bar;
        __builtin_amdgcn_s_waitcnt(0);
        unsigned nloc = b.st[0], nx = b.st[1];
        if (nloc == 0u) { xcd_barrier_complete(bar, b.x, nloc, nx); b.st[0] = nloc; b.st[1] = nx; }
        const unsigned old = xb_add(&bar[XB_XSUB(b.x)], 1u);
        const unsigned gen = old / nloc;
        if (old + 1u == (gen + 1u) * nloc) {
            __builtin_amdgcn_fence(__ATOMIC_RELEASE, "agent");
            asm volatile("s_waitcnt vmcnt(0)" ::: "memory");
            const unsigned og = xb_add(&bar[XB_TOP], 1u);
            const unsigned tg = og / nx;
            if (og + 1u == (tg + 1u) * nx) xb_add(&bar[XB_TOPGEN], 1u);
            else XB_SPIN(xb_ld(&bar[XB_TOPGEN]) == tg, bar);
            __builtin_amdgcn_fence(__ATOMIC_ACQUIRE, "agent");
            xb_add(&bar[XB_XGEN(b.x)], 1u);
            asm volatile("s_waitcnt vmcnt(0)" ::: "memory");
        } else {
            XB_SPIN(xb_ld(&bar[XB_XGEN(b.x)]) == gen, bar);
            __builtin_amdgcn_fence(__ATOMIC_ACQUIRE, "agent");
            asm volatile("s_waitcnt vmcnt(0)" ::: "memory");
        }
    }
    __syncthreads();
}


__global__ void __launch_bounds__(512, 2) fwd_mega(Params p_unused) {
    extern __shared__ __attribute__((aligned(16))) unsigned char lds_raw[];
    LAS unsigned char* lds = (LAS unsigned char*)lds_raw;
    cg::grid_group grid = cg::this_grid();
    if (threadIdx.x < 64) ((LAS unsigned*)(lds + MISC_OFF))[threadIdx.x] = 0u;
    __syncthreads();
    if (gridDim.x > 65535u) grid.sync();
    { KP p = kargs(); (void)xcd_barrier_post((unsigned*)(p->ws + WS_BAR), (volatile LAS unsigned*)(lds + MISC_OFF)); }
#define WSP(T, off) ((T*)(ws + (off)))
#define XSYNC() do { KP p_ = kargs(); XcdBarrier b_; b_.bar = (unsigned*)(p_->ws + WS_BAR); b_.x = xb_xcc_id(); b_.st = (volatile LAS unsigned*)(lds + MISC_OFF); xcd_barrier(b_); } while (0)
#define REP(k) for (int rep_ = 0; rep_ < ((DUP_PHASE == (k)) ? 2 : 1); ++rep_)
    REP(0) { KP p = kargs(); p0_phase(lds, p); }
    XSYNC();
    REP(1) { KP p = kargs(); unsigned char* ws = p->ws; E1 e{WSP(bf16, WS_PROJ), p->b_gate, p->out};
      big_gemm(lds, WSP(bf16, WS_XN), DM, WSP(bf16, WS_W1), DM, N1, DM, e); small_gemm(lds, WSP(bf16, WS_XN) + (size_t)MP * DM, DM, WSP(bf16, WS_W1), DM, N1, DM, e);
      bubble_convert(lds, p, (MP / 256 * (N1 / 256)) % (int)gridDim.x, I_MID, I_MID + I_UP); }
    XSYNC();
    REP(2) { KP p = kargs(); unsigned char* ws = p->ws; p2_phase(lds, p, WSP(bf16, WS_PROJ), WSP(bf16, WS_MIX)); }
    XSYNC();
    { KP p = kargs(); unsigned char* ws = p->ws;
      EpiMerge em{WSP(bf16, WS_PROJ), WSP(bf16, WS_MERGED)};
      pg8::Gemm g{WSP(bf16, WS_MIX), WSP(bf16, WS_WBA), MP, DM, DM, DM, DM}; pg8::StaticOrder S; S.init(MP, DM, (int)gridDim.x, (int)blockIdx.x);
      pg8::gemm_phase<EpiMerge, pg8::StaticOrder, true, true>(lds, g, S, em);
      E2s es{WSP(bf16, WS_PROJ), WSP(bf16, WS_MERGED)};
      small_gemm_dual(lds, WSP(bf16, WS_MIX) + (size_t)MP * DM, DM, WSP(bf16, WS_WBA), DM, DM, es);
      lower_half_convert(lds, p, NITEMS - I_PG, NITEMS - I_PG / 2); }
    XSYNC();
    REP(4) { KP p = kargs(); unsigned char* ws = p->ws; E3 e{p->x_prompt, p->x_sample, p->out + OFF_Y, p->ffn_norm_w, WSP(bf16, WS_XN), WSP(float, WS_SS1)};
      big_gemm(lds, WSP(bf16, WS_MERGED), DM, WSP(bf16, WS_WOUT), DM, DM, DM, e); small_gemm(lds, WSP(bf16, WS_MERGED) + (size_t)MP * DM, DM, WSP(bf16, WS_WOUT), DM, DM, DM, e);
      lower_half_convert(lds, p, NITEMS - I_PG / 2, NITEMS); }
    XSYNC();
    { KP p = kargs(); unsigned char* ws = p->ws;
      EpiConv ec{WSP(bf16, WS_ACT), p->out, WSP(float, WS_SS1), p->conv_w, p->conv_b, WSP(float, WS_HB), (LAS float*)(lds + 131072)};
      pg8::Gemm g{WSP(bf16, WS_XN), WSP(bf16, WS_WUP), MP, NUP, DM, DM, DM}; pg8::StaticOrder S; S.init(MP, NUP, (int)gridDim.x, (int)blockIdx.x);
      pg8::gemm_phase<EpiConv, pg8::StaticOrder, true, true>(lds, g, S, ec);
      E4s e{WSP(float, WS_HS), p->out, WSP(float, WS_SS1)};
      small_gemm(lds, WSP(bf16, WS_XN) + (size_t)MP * DM, DM, WSP(bf16, WS_WUP), DM, NUP, DM, e);
      const int first6 = (MP / 256 * (NUP / 256)) % (int)gridDim.x;
      bubble_convert(lds, p, first6, I_MID + I_UP, NITEMS - I_PG);
      if ((int)blockIdx.x >= first6) {
          E6a e6{WSP(bf16, WS_PP)}; EpiAd<E6a> E{e6};
          pg8::Gemm g2{WSP(bf16, WS_PBF), WSP(bf16, WS_WPP), MP, DM, PLE, PLE, PLE}; pg8::StaticOrder S2; S2.init(MP, DM, (int)gridDim.x - first6, (int)blockIdx.x - first6);
          pg8::gemm_phase<EpiAd<E6a>, pg8::StaticOrder, true, true>(lds, g2, S2, E);
      }
      { E6a e6{WSP(bf16, WS_PP)}; small_gemm(lds, WSP(bf16, WS_PBF) + (size_t)MP * PLE, PLE, WSP(bf16, WS_WPP), PLE, DM, PLE, e6); } }
    XSYNC();
    { KP p = kargs(); unsigned char* ws = p->ws; conv_fix_phase(p, WSP(float, WS_HB), WSP(float, WS_HS), WSP(bf16, WS_ACT)); }
    XSYNC();
    { KP p = kargs(); unsigned char* ws = p->ws; E5 e{p->out + OFF_Y, p->ple_norm_w, WSP(bf16, WS_XN3), WSP(float, WS_SS2)};
      big_gemm(lds, WSP(bf16, WS_ACT), DFF, WSP(bf16, WS_WDOWN), DFF, DM, DFF, e); small_gemm(lds, WSP(bf16, WS_ACT) + (size_t)MP * DFF, DFF, WSP(bf16, WS_WDOWN), DFF, DM, DFF, e); }
    XSYNC();
    { KP p = kargs(); unsigned char* ws = p->ws; E6b e{WSP(bf16, WS_PP), p->out + OFF_Y, WSP(float, WS_SS2)};
      big_gemm(lds, WSP(bf16, WS_XN3), DM, WSP(bf16, WS_WPG), DM, DM, DM, e); small_gemm(lds, WSP(bf16, WS_XN3) + (size_t)MP * DM, DM, WSP(bf16, WS_WPG), DM, DM, DM, e); }
#undef WSP
}

extern "C" void kernel_launch(void* const* d_in, const int* in_sizes, int n_in, void* d_out, int out_size, void* d_ws, size_t ws_size, hipStream_t stream) {
    static int grid = 0;
    if (grid == 0) {
        if (n_in != 28 || out_size != (int)OUT_TOTAL || ws_size < WS_END) { fprintf(stderr, "kernel_launch: unexpected shapes: n_in %d out %d ws %zu\n", n_in, out_size, ws_size); grid = -1; return; }
        int dev = 0, cus = 0, per_cu = 0;
        (void)hipGetDevice(&dev); (void)hipDeviceGetAttribute(&cus, hipDeviceAttributeMultiprocessorCount, dev);
        if (hipFuncSetAttribute((const void*)fwd_mega, hipFuncAttributeMaxDynamicSharedMemorySize, LDS_BYTES) != hipSuccess) { fprintf(stderr, "kernel_launch: hipFuncSetAttribute failed\n"); grid = -1; return; }
        if (hipOccupancyMaxActiveBlocksPerMultiprocessor(&per_cu, (const void*)fwd_mega, 512, LDS_BYTES) != hipSuccess || per_cu < 1) { fprintf(stderr, "kernel_launch: occupancy query says %d\n", per_cu); per_cu = 1; }
        (void)hipGetLastError();
        grid = cus * 1;
    }
    if (grid < 0) return;
    Params p{};
    const float** pp = (const float**)&p;
    for (int i = 0; i < 28; ++i) pp[i] = (const float*)d_in[i];
    p.out = (float*)d_out; p.ws = (unsigned char*)d_ws;
    if (hipMemsetAsync((char*)d_ws + WS_BAR, 0, XCD_BAR_WORDS * 4, stream) != hipSuccess) { fprintf(stderr, "kernel_launch: memset of the barrier words failed\n"); return; }
    void* args[] = {&p};
    hipError_t e = hipLaunchCooperativeKernel((const void*)fwd_mega, dim3(grid), dim3(512), args, LDS_BYTES, stream);
    if (e != hipSuccess) fprintf(stderr, "kernel_launch: cooperative launch failed: %s (grid %d)\n", hipGetErrorString(e), grid);
}
```

```cpp
#include <hip/hip_runtime.h>
#include <hip/hip_cooperative_groups.h>
#include <cstdio>
#include <cstdint>
namespace cg = cooperative_groups;

#define LAS __attribute__((address_space(3)))
typedef unsigned short bf16;
typedef unsigned u32x4 __attribute__((ext_vector_type(4)));
typedef unsigned u32x2 __attribute__((ext_vector_type(2)));
typedef float f32x4 __attribute__((ext_vector_type(4)));
typedef short bf16x8 __attribute__((ext_vector_type(8)));

constexpr int DM = 2048, MP = 8192, MS = 32, MALL = MP + MS, SEQ = 2048;
constexpr int N1 = 7680, DFF = 5632, NUP = 11264, PLE = 256;
constexpr int C_K = 1024, C_V = 1280, C_GU = 1536, C_GV = 2560, C_GATE = 3584;
constexpr float EPS = 1e-6f;
constexpr size_t OFF_Y = 0, OFF_KP = 16842752, OFF_VP = 16973824, OFF_KS = 17104896, OFF_VS = 18153472,
                 OFF_GP = 19202048, OFF_GS = 19726336, OFF_CP = 19759104, OFF_CS = 19849216, OUT_TOTAL = 20570112;
constexpr size_t MiB = 1u << 20;
constexpr size_t WS_WUP = 1 * MiB, WS_WDOWN = 45 * MiB, WS_WPG = 67 * MiB, WS_WPP = 75 * MiB, WS_XN = 76 * MiB;
constexpr size_t WS_W1 = 109 * MiB, WS_WBA = 139 * MiB, WS_WBG = 143 * MiB, WS_WOUT = 147 * MiB;
constexpr size_t WS_PROJ = 155 * MiB, WS_MIX = 276 * MiB, WS_MERGED = 309 * MiB, WS_PBF = 342 * MiB;
constexpr size_t WS_BAR = 262144;
constexpr size_t WS_SS1 = 0, WS_SS2 = 65536, WS_XN3 = 254 * MiB, WS_HB = 109 * MiB, WS_HS = 116 * MiB;
constexpr size_t WS_ACT = 165 * MiB, WS_PP = 118 * MiB, WS_END = 347 * MiB;
static_assert(WS_PROJ + (size_t)MALL * N1 * 2 <= WS_MIX && WS_MIX + (size_t)MALL * 2048 * 2 <= WS_MERGED && WS_MERGED + (size_t)MALL * 2048 * 2 <= WS_PBF, "ws map early");
static_assert(WS_ACT + (size_t)MALL * DFF * 2 <= WS_XN3 && WS_XN3 + (size_t)MALL * DM * 2 <= WS_PBF && WS_PBF + (size_t)MALL * PLE * 2 <= WS_END && WS_PP + (size_t)MALL * DM * 2 <= WS_ACT && WS_HS + (size_t)MS * NUP * 4 <= WS_PP && WS_HB + (size_t)32 * 4 * NUP * 4 <= WS_HS && WS_HS + (size_t)MS * NUP * 4 <= WS_ACT, "ws map late");
constexpr int MISC_OFF = 131072 + 8192;
constexpr int WL_OFF = 131072 + 8192 + 256, RSL_OFF = WL_OFF + 4096;
constexpr int LDS_BYTES = RSL_OFF + 1024;
#ifndef DUP_PHASE
#define DUP_PHASE -1
#endif

struct Params {
    const float *x_prompt, *x_sample, *p_prompt, *p_sample, *st_k, *st_v, *st_conv;
    const float *attn_norm_w, *w_in, *q_norm_w, *k_norm_w, *sinks, *sgu_norm_w, *sgu_w, *sgu_b;
    const float *w_br_attn, *w_br_gm, *w_gate, *b_gate, *w_out, *ffn_norm_w, *w_up, *conv_w, *conv_b, *w_down, *ple_norm_w, *w_ple_gate, *w_ple_proj;
    float* out; unsigned char* ws;
};

typedef const __attribute__((address_space(4))) Params* KP;
__device__ __forceinline__ KP kargs() { KP k = (KP)__builtin_amdgcn_kernarg_segment_ptr(); asm volatile("" : "+s"(k)); return k; }

__device__ __forceinline__ int tid_fresh() { int t = threadIdx.x; asm volatile("" : "+v"(t)); return t; }
typedef float f32x2_t __attribute__((ext_vector_type(2)));
typedef __bf16 bf16x2_t __attribute__((ext_vector_type(2)));
__device__ __forceinline__ unsigned pk2m(float lo, float hi) { f32x2_t v = {lo, hi}; bf16x2_t b = __builtin_convertvector(v, bf16x2_t); return __builtin_bit_cast(unsigned, b); }
__device__ __forceinline__ unsigned pk2(float lo, float hi) { unsigned r; asm("v_cvt_pk_bf16_f32 %0, %1, %2" : "=v"(r) : "v"(lo), "v"(hi)); return r; }
__device__ __forceinline__ float bf_lo(unsigned u) { return __builtin_bit_cast(float, u << 16); }
__device__ __forceinline__ float bf_hi(unsigned u) { return __builtin_bit_cast(float, u & 0xffff0000u); }
__device__ __forceinline__ void unpack8(const u32x4 u, float (&f)[8]) {
    f[0] = bf_lo(u.x); f[1] = bf_hi(u.x); f[2] = bf_lo(u.y); f[3] = bf_hi(u.y); f[4] = bf_lo(u.z); f[5] = bf_hi(u.z); f[6] = bf_lo(u.w); f[7] = bf_hi(u.w);
}
__device__ __forceinline__ u32x4 pack8m(const float (&f)[8]) { u32x4 u; u.x = pk2m(f[0], f[1]); u.y = pk2m(f[2], f[3]); u.z = pk2m(f[4], f[5]); u.w = pk2m(f[6], f[7]); return u; }
__device__ __forceinline__ u32x4 pack8(const float (&f)[8]) { u32x4 u; u.x = pk2(f[0], f[1]); u.y = pk2(f[2], f[3]); u.z = pk2(f[4], f[5]); u.w = pk2(f[6], f[7]); return u; }
__device__ __forceinline__ float wave_sum(float v) {
#pragma unroll
    for (int o = 1; o < 64; o <<= 1) v += __shfl_xor(v, o);
    return v;
}
__device__ __forceinline__ float wave_max(float v) {
#pragma unroll
    for (int o = 1; o < 64; o <<= 1) v = fmaxf(v, __shfl_xor(v, o));
    return v;
}
__device__ __forceinline__ float sigmoidf_(float z) { return __builtin_amdgcn_rcpf(1.f + __expf(-z)); }
__device__ __forceinline__ float gelu_tanh(float x) { const float u = 0.7978845608028654f * (x + 0.044715f * x * x * x); return x * __builtin_amdgcn_rcpf(1.f + __expf(-2.f * u)); }
__device__ __forceinline__ float silu_(float x) { return x * __builtin_amdgcn_rcpf(1.f + __expf(-x)); }

namespace pg8 {
#define PG8_LAS __attribute__((address_space(3)))
typedef unsigned short bf16_t;
typedef short bf16x8 __attribute__((ext_vector_type(8)));
typedef float f32x4 __attribute__((ext_vector_type(4)));
constexpr int BM = 256, BK = 64, HALF = 128, HTB = HALF * BK * 2, STAGE_BYTES = 8 * HTB, NXCD = 8, WGM = 8;

__host__ __device__ __forceinline__ int lds_byte(int r, int c) { const int st = (r >> 4) * 2 + (c >> 5), rr = r & 15, cc = c & 31, ob = rr * 64 + cc * 2; return st * 1024 + (ob ^ (((ob >> 9) & 1) << 5)); }
__host__ __device__ __forceinline__ void stage_rc(int b, int& R, int& C) { const int st = b / 1024, sb = b % 1024, swz = sb ^ (((sb >> 9) & 1) << 5); R = (st >> 1) * 16 + swz / 64; C = (st & 1) * 32 + (swz % 64) / 2; }
__host__ __device__ __forceinline__ int perm32(int rho) { const int n = rho >> 4, i = rho & 15; return 8 * (i >> 2) + 4 * n + (i & 3); }

struct Unit { int pm, pn; };
struct Gemm { const bf16_t* A; const bf16_t* Bt; int M, N, K, lda, ldb; };

struct StaticOrder {
    int nM, nN, nwg, G, c;
    __host__ __device__ void init(int M, int N, int G_, int c_) { nM = M / BM; nN = N / BM; nwg = nM * nN; G = G_; c = c_; }
    __host__ __device__ bool next(int i, Unit& u) const {
        const long L = (long)i * G + c; if (L >= nwg) return false;
        int wgid = (int)L; { const int q = nwg / NXCD, r = nwg % NXCD, xcd = wgid % NXCD, off = wgid / NXCD; wgid = (xcd < r ? xcd * (q + 1) : r * (q + 1) + (xcd - r) * q) + off; }
        const int nig = WGM * nN, gid = wgid / nig, fm = gid * WGM, gsz = (nM - fm) < WGM ? (nM - fm) : WGM;
        u.pm = fm + ((wgid % nig) % gsz); u.pn = (wgid % nig) / gsz; return true;
    }
};

template <class Epi, class Sched, bool ALIGN_EPI = false, bool SP2 = false>
__device__ __forceinline__ void gemm_phase(PG8_LAS unsigned char* lds, const Gemm g, const Sched& S, const Epi& E) {
    const int tid = tid_fresh(), wid = __builtin_amdgcn_readfirstlane(tid >> 6), lane = tid & 63, wr = wid >> 2, wc = wid & 3, fr = lane & 15, fq = lane >> 4;
    const int K = g.K, nt = K / BK;
    unsigned voffA[2], voffB[2];
#pragma unroll
    for (int i = 0; i < 2; ++i) { int R, C; stage_rc(tid * 16 + i * 8192, R, C); const int Rb = Epi::PERM ? ((R & ~31) + perm32(R & 31)) : R;
        voffA[i] = (unsigned)(R * g.lda + C) * 2u; voffB[i] = (unsigned)(Rb * g.ldb + C) * 2u; }
    const size_t kstep = (size_t)(BK * 2);
    const size_t hstepA = (size_t)HALF * g.lda * 2, hstepB = (size_t)HALF * g.ldb * 2;
    const size_t tstepA = 2 * hstepA, tstepB = 2 * hstepB;
    const unsigned ldsw = (unsigned)wid * 1024u;
    const int aoff = lds_byte(wr * 64 + fr, fq * 8), boff = lds_byte(wc * 32 + fr, fq * 8);
#define PG8_SA(b, h) (((b) * 2 + (h)) * HTB)
#define PG8_SB(b, h) ((4 + (b) * 2 + (h)) * HTB)
#define PG8_STAGE(bufoff, gbase, voff) do { _Pragma("unroll") for (int _i = 0; _i < 2; ++_i) \
        __builtin_amdgcn_global_load_lds((const unsigned*)((const char*)(gbase) + (voff)[_i]), (PG8_LAS unsigned*)(lds + (bufoff) + ldsw + _i * 8192), 16, 0, 0); } while (0)
#define PG8_LDA(dst, b, h) do { _Pragma("unroll") for (int m = 0; m < 4; ++m) _Pragma("unroll") for (int k = 0; k < 2; ++k) dst[m][k] = *(const PG8_LAS bf16x8*)(lds + PG8_SA(b, h) + aoff + m * 2048 + k * 1024); } while (0)
#define PG8_LDB(dst, b, h) do { _Pragma("unroll") for (int n = 0; n < 2; ++n) _Pragma("unroll") for (int k = 0; k < 2; ++k) dst[n][k] = *(const PG8_LAS bf16x8*)(lds + PG8_SB(b, h) + boff + n * 2048 + k * 1024); } while (0)
#define PG8_MMA(ai, bj, At, Bt) do { __builtin_amdgcn_s_setprio(1); _Pragma("unroll") for (int m = 0; m < 4; ++m) _Pragma("unroll") for (int n = 0; n < 2; ++n) _Pragma("unroll") for (int k = 0; k < 2; ++k) \
        acc[ai][bj][m][n] = __builtin_amdgcn_mfma_f32_16x16x32_bf16(Bt[n][k], At[m][k], acc[ai][bj][m][n], 0, 0, 0); __builtin_amdgcn_s_setprio(0); } while (0)
#define PG8_WAIT_V(n) asm volatile("s_waitcnt vmcnt(" #n ")" ::: "memory")
#define PG8_WAIT_L(n) asm volatile("s_waitcnt lgkmcnt(" #n ")" ::: "memory")
#define PG8_BAR __builtin_amdgcn_s_barrier()
#define PG8_SCHED __builtin_amdgcn_sched_barrier(0)
    Unit cur, nxt; int ui = 0;
    if (!S.next(0, cur)) return;
    f32x4 acc[2][2][4][2];
#pragma unroll
    for (int a = 0; a < 2; ++a)
#pragma unroll
        for (int b = 0; b < 2; ++b)
#pragma unroll
            for (int m = 0; m < 4; ++m)
#pragma unroll
                for (int n = 0; n < 2; ++n) acc[a][b][m][n] = (f32x4){0.f, 0.f, 0.f, 0.f};
    bf16x8 At[4][2], B0[2][2], B1[2][2];
    const char* cA = (const char*)g.A + (size_t)cur.pm * tstepA; const char* cB = (const char*)g.Bt + (size_t)cur.pn * tstepB;
    if constexpr (SP2) {
        PG8_STAGE(PG8_SB(0, 0), cB, voffB); PG8_STAGE(PG8_SB(0, 1), cB + hstepB, voffB); PG8_STAGE(PG8_SA(0, 0), cA, voffA); PG8_STAGE(PG8_SA(0, 1), cA + hstepA, voffA);
        if (wr == 1) PG8_BAR;
        PG8_WAIT_V(2); PG8_BAR;
        PG8_STAGE(PG8_SB(1, 0), cB + kstep, voffB); PG8_STAGE(PG8_SA(1, 0), cA + kstep, voffA); PG8_STAGE(PG8_SB(1, 1), cB + hstepB + kstep, voffB);
        PG8_WAIT_V(6); PG8_BAR;
    } else {
        PG8_STAGE(PG8_SB(0, 0), cB, voffB); PG8_STAGE(PG8_SA(0, 0), cA, voffA); PG8_STAGE(PG8_SB(0, 1), cB + hstepB, voffB); PG8_STAGE(PG8_SA(0, 1), cA + hstepA, voffA);
        if (wr == 1) PG8_BAR;
        PG8_WAIT_V(4); PG8_BAR;
        PG8_STAGE(PG8_SB(1, 0), cB + kstep, voffB); PG8_STAGE(PG8_SA(1, 0), cA + kstep, voffA); PG8_STAGE(PG8_SB(1, 1), cB + hstepB + kstep, voffB);
        PG8_WAIT_V(6); PG8_BAR;
    }
    for (;;) {
        const bool has_next = S.next(ui + 1, nxt);
        const char* nA = has_next ? (const char*)g.A + (size_t)nxt.pm * tstepA : cA; const char* nB = has_next ? (const char*)g.Bt + (size_t)nxt.pn * tstepB : cB;
        for (int t = 0; t < nt; t += 2) {
            if constexpr (Epi::MID) { if (t == (nt >> 1)) E.mid(acc, cur); }
            const bool last = (t == nt - 2);
            const char* a1 = cA + (size_t)(t + 1) * kstep;
            const char* a2 = last ? nA : cA + (size_t)(t + 2) * kstep; const char* b2 = last ? nB : cB + (size_t)(t + 2) * kstep;
            const char* a3 = a2 + kstep; const char* b3 = b2 + kstep;
            if constexpr (SP2) {
            PG8_LDB(B0, 0, 0); PG8_LDB(B1, 0, 1); PG8_SCHED; PG8_LDA(At, 0, 0); PG8_STAGE(PG8_SA(1, 1), a1 + hstepA, voffA);
            PG8_WAIT_V(8); PG8_WAIT_L(0); PG8_BAR; PG8_MMA(0, 0, At, B0); PG8_MMA(0, 1, At, B1); PG8_BAR; PG8_SCHED;
            PG8_LDA(At, 0, 1); PG8_STAGE(PG8_SB(0, 0), b2, voffB); PG8_STAGE(PG8_SB(0, 1), b2 + hstepB, voffB); PG8_STAGE(PG8_SA(0, 0), a2, voffA);
            PG8_WAIT_V(8); PG8_WAIT_L(0); PG8_BAR; PG8_MMA(1, 0, At, B0); PG8_MMA(1, 1, At, B1); PG8_BAR; PG8_SCHED;
            PG8_LDB(B0, 1, 0); PG8_LDB(B1, 1, 1); PG8_SCHED; PG8_LDA(At, 1, 0); PG8_STAGE(PG8_SA(0, 1), a2 + hstepA, voffA);
            PG8_WAIT_V(8); PG8_WAIT_L(0); PG8_BAR; PG8_MMA(0, 0, At, B0); PG8_MMA(0, 1, At, B1); PG8_BAR; PG8_SCHED;
            PG8_LDA(At, 1, 1); PG8_STAGE(PG8_SB(1, 0), b3, voffB); PG8_STAGE(PG8_SB(1, 1), b3 + hstepB, voffB); PG8_STAGE(PG8_SA(1, 0), a3, voffA);
            PG8_WAIT_V(8); PG8_WAIT_L(0); PG8_BAR; PG8_MMA(1, 0, At, B0); PG8_MMA(1, 1, At, B1); PG8_BAR; PG8_SCHED;
            } else {
            PG8_LDB(B0, 0, 0); PG8_SCHED; PG8_LDA(At, 0, 0); PG8_STAGE(PG8_SA(1, 1), a1 + hstepA, voffA);
            PG8_WAIT_L(8); PG8_BAR; PG8_WAIT_L(0); PG8_MMA(0, 0, At, B0); PG8_BAR; PG8_SCHED;
            PG8_LDB(B1, 0, 1); PG8_STAGE(PG8_SB(0, 0), b2, voffB);
            PG8_BAR; PG8_WAIT_L(0); PG8_MMA(0, 1, At, B1); PG8_BAR;
            PG8_LDA(At, 0, 1); PG8_STAGE(PG8_SA(0, 0), a2, voffA);
            PG8_BAR; PG8_WAIT_L(0); PG8_MMA(1, 0, At, B0); PG8_BAR; PG8_SCHED;
            PG8_STAGE(PG8_SB(0, 1), b2 + hstepB, voffB);
            PG8_WAIT_V(6); PG8_BAR; PG8_MMA(1, 1, At, B1); PG8_BAR;
            PG8_LDB(B0, 1, 0); PG8_SCHED; PG8_LDA(At, 1, 0); PG8_STAGE(PG8_SA(0, 1), a2 + hstepA, voffA);
            PG8_WAIT_L(8); PG8_BAR; PG8_WAIT_L(0); PG8_MMA(0, 0, At, B0); PG8_BAR; PG8_SCHED;
            PG8_LDB(B1, 1, 1); PG8_STAGE(PG8_SB(1, 0), b3, voffB);
            PG8_BAR; PG8_WAIT_L(0); PG8_MMA(0, 1, At, B1); PG8_BAR;
            PG8_LDA(At, 1, 1); PG8_STAGE(PG8_SA(1, 0), a3, voffA);
            PG8_BAR; PG8_WAIT_L(0); PG8_MMA(1, 0, At, B0); PG8_BAR; PG8_SCHED;
            PG8_STAGE(PG8_SB(1, 1), b3 + hstepB, voffB);
            PG8_WAIT_V(6); PG8_BAR; PG8_MMA(1, 1, At, B1); PG8_BAR;
            }
        }
        if constexpr (ALIGN_EPI) { if (wr == 0) PG8_BAR; }
        E(acc, cur, wr, wc, fr, fq);
        if (!has_next) break;
#pragma unroll
        for (int a = 0; a < 2; ++a)
#pragma unroll
            for (int b = 0; b < 2; ++b)
#pragma unroll
                for (int m = 0; m < 4; ++m)
#pragma unroll
                    for (int n = 0; n < 2; ++n) acc[a][b][m][n] = (f32x4){0.f, 0.f, 0.f, 0.f};
        cur = nxt; cA = nA; cB = nB; ++ui;
        if constexpr (ALIGN_EPI) { if (wr == 1) PG8_BAR; }
    }
    PG8_WAIT_V(0);
    if constexpr (!ALIGN_EPI) { if (wr == 0) PG8_BAR; }
    PG8_BAR;
#undef PG8_SA
#undef PG8_SB
#undef PG8_STAGE
#undef PG8_LDA
#undef PG8_LDB
#undef PG8_MMA
#undef PG8_WAIT_V
#undef PG8_WAIT_L
#undef PG8_BAR
#undef PG8_SCHED
}
}

template <class F> struct EpiAd {
    static constexpr bool PERM = true, AFTER_DRAIN = false, MID = false;
    F f;
    __device__ __forceinline__ void operator()(const pg8::f32x4 (&acc)[2][2][4][2], const pg8::Unit& u, int wr, int wc, int fr, int fq) const {
        const int row0 = u.pm * 256 + wr * 64 + fr, col0 = u.pn * 256 + wc * 32 + 8 * fq;
#pragma unroll
        for (int ai = 0; ai < 2; ++ai)
#pragma unroll
            for (int m = 0; m < 4; ++m)
            {
                float q = 0.f;
#pragma unroll
                for (int bj = 0; bj < 2; ++bj) {
                    float v[8];
#pragma unroll
                    for (int e = 0; e < 4; ++e) { v[e] = acc[ai][bj][m][0][e]; v[4 + e] = acc[ai][bj][m][1][e]; }
                    q += f.apply(row0 + ai * 128 + m * 16, col0 + bj * 128, v);
                }
                if constexpr (F::ROWSUM) {
                    q += __shfl_xor(q, 16); q += __shfl_xor(q, 32);
                    if (fq == 0) __hip_atomic_fetch_add(f.ss + row0 + ai * 128 + m * 16, q, __ATOMIC_RELAXED, __HIP_MEMORY_SCOPE_AGENT);
                }
            }
    }
};

struct EpiMerge {
    static constexpr bool PERM = true, AFTER_DRAIN = false, MID = true;
    const bf16* proj; bf16* merged;
    __device__ __forceinline__ void mid(pg8::f32x4 (&acc)[2][2][4][2], const pg8::Unit& u) const {
        const int tid = tid_fresh(), wid = __builtin_amdgcn_readfirstlane(tid >> 6), lane = tid & 63, wr = wid >> 2, wc = wid & 3, fr = lane & 15, fq = lane >> 4;
        const int row0 = u.pm * 256 + wr * 64 + fr, col0 = u.pn * 256 + wc * 32 + 8 * fq;
#pragma unroll
        for (int ai = 0; ai < 2; ++ai) {
            u32x4 ga[4][2], gb[4][2];
#pragma unroll
            for (int m = 0; m < 4; ++m)
#pragma unroll
                for (int bj = 0; bj < 2; ++bj) {
                    const bf16* gp = proj + (size_t)(row0 + ai * 128 + m * 16) * N1 + C_GATE + col0 + bj * 128;
                    ga[m][bj] = *(const u32x4*)gp; gb[m][bj] = *(const u32x4*)(gp + DM);
                }
#pragma unroll
            for (int m = 0; m < 4; ++m)
#pragma unroll
                for (int bj = 0; bj < 2; ++bj) {
                    float a[8], b[8]; unpack8(ga[m][bj], a); unpack8(gb[m][bj], b);
#pragma unroll
                    for (int e = 0; e < 4; ++e) {
                        acc[ai][bj][m][0][e] *= b[e] * __builtin_amdgcn_rcpf(fmaxf(a[e], 1e-30f));
                        acc[ai][bj][m][1][e] *= b[4 + e] * __builtin_amdgcn_rcpf(fmaxf(a[4 + e], 1e-30f));
                    }
                }
            __builtin_amdgcn_sched_barrier(0);
        }
    }
    __device__ __forceinline__ void operator()(const pg8::f32x4 (&acc)[2][2][4][2], const pg8::Unit& u, int, int, int, int) const {
        const int tid = tid_fresh(), wid = __builtin_amdgcn_readfirstlane(tid >> 6), lane = tid & 63, wr = wid >> 2, wc = wid & 3, fr = lane & 15, fq = lane >> 4;
        const int row0 = u.pm * 256 + wr * 64 + fr, col0 = u.pn * 256 + wc * 32 + 8 * fq;
#pragma unroll
        for (int ai = 0; ai < 2; ++ai)
#pragma unroll
            for (int m = 0; m < 4; ++m)
#pragma unroll
                for (int bj = 0; bj < 2; ++bj) {
                    const int row = row0 + ai * 128 + m * 16, col = col0 + bj * 128;
                    float ga[8], v[8]; unpack8(*(const u32x4*)(proj + (size_t)row * N1 + C_GATE + col), ga);
#pragma unroll
                    for (int e = 0; e < 4; ++e) { v[e] = acc[ai][bj][m][0][e] * ga[e]; v[4 + e] = acc[ai][bj][m][1][e] * ga[4 + e]; }
                    *(u32x4*)(merged + (size_t)row * DM + col) = pack8(v);
                }
    }
};

template <class F, bool ALIGN = true>
__device__ __forceinline__ void big_gemm(LAS unsigned char* lds, const bf16* A, int lda, const bf16* Bt, int ldb, int N, int K, const F& f) {
    pg8::Gemm g{A, Bt, MP, N, K, lda, ldb}; pg8::StaticOrder S; S.init(MP, N, (int)gridDim.x, (int)blockIdx.x);
    EpiAd<F> E{f};
    pg8::gemm_phase<EpiAd<F>, pg8::StaticOrder, ALIGN, true>(lds, g, S, E);
}

template <class F>
__device__ __forceinline__ void small_gemm(LAS unsigned char* lds, const bf16* A  , int lda, const bf16* Bt, int ldb, int N, int K, const F& f) {
    const int tid = tid_fresh(), wave = tid >> 6, lane = tid & 63, fr = lane & 15, fq = lane >> 4;
    LAS float* red = (LAS float*)lds;
    const int ntask = N / 16, kw = K / 8;
    for (int task = (int)(gridDim.x - 1 - blockIdx.x); task < ntask; task += gridDim.x) {
        const int n0 = task * 16;
        f32x4 c0 = {0.f, 0.f, 0.f, 0.f}, c1 = {0.f, 0.f, 0.f, 0.f};
        const bf16* a0 = A + (size_t)fr * lda + wave * kw + fq * 8;
        const bf16* a1 = a0 + (size_t)16 * lda;
        const bf16* bp = Bt + (size_t)(n0 + fr) * ldb + wave * kw + fq * 8;
#pragma unroll 8
        for (int k = 0; k < kw; k += 32) {
            const bf16x8 av0 = *(const bf16x8*)(a0 + k), av1 = *(const bf16x8*)(a1 + k), bv = *(const bf16x8*)(bp + k);
            c0 = __builtin_amdgcn_mfma_f32_16x16x32_bf16(av0, bv, c0, 0, 0, 0);
            c1 = __builtin_amdgcn_mfma_f32_16x16x32_bf16(av1, bv, c1, 0, 0, 0);
        }
#pragma unroll
        for (int r = 0; r < 4; ++r) { red[(wave * 32 + fq * 4 + r) * 16 + fr] = c0[r]; red[(wave * 32 + 16 + fq * 4 + r) * 16 + fr] = c1[r]; }
        __syncthreads();
        if (tid < 64) {
            const int row = tid >> 1, c8 = (tid & 1) * 8;
            float v[8];
#pragma unroll
            for (int e = 0; e < 8; ++e) v[e] = 0.f;
#pragma unroll
            for (int w = 0; w < 8; ++w)
#pragma unroll
                for (int e = 0; e < 8; ++e) v[e] += red[(w * 32 + row) * 16 + c8 + e];
            const float q = f.apply(MP + row, n0 + c8, v);
            if constexpr (F::ROWSUM) __hip_atomic_fetch_add(f.ss + MP + row, q, __ATOMIC_RELAXED, __HIP_MEMORY_SCOPE_AGENT);
        }
        __syncthreads();
    }
}

template <class F>
__device__ __forceinline__ void small_gemm_dual(LAS unsigned char* lds, const bf16* A, int lda, const bf16* Bt, int ldb, int N, const F& f) {
    const int tid = tid_fresh(), wave = tid >> 6, lane = tid & 63, fr = lane & 15, fq = lane >> 4;
    LAS float* red = (LAS float*)lds;
    const int ntask = N / 16, kw = 256;
    for (int task = (int)(gridDim.x - 1 - blockIdx.x); task < ntask; task += gridDim.x) {
        const int n0 = task * 16;
        f32x4 c0 = {0.f, 0.f, 0.f, 0.f}, c1 = {0.f, 0.f, 0.f, 0.f};
        const bf16* a0 = A + (size_t)fr * lda + wave * kw + fq * 8;
        const bf16* a1 = a0 + (size_t)16 * lda;
        const bf16* bp = Bt + (size_t)(n0 + fr) * ldb + wave * kw + fq * 8;
#pragma unroll
        for (int k = 0; k < kw; k += 32) {
            const bf16x8 av0 = *(const bf16x8*)(a0 + k), av1 = *(const bf16x8*)(a1 + k), bv = *(const bf16x8*)(bp + k);
            c0 = __builtin_amdgcn_mfma_f32_16x16x32_bf16(av0, bv, c0, 0, 0, 0);
            c1 = __builtin_amdgcn_mfma_f32_16x16x32_bf16(av1, bv, c1, 0, 0, 0);
        }
#pragma unroll
        for (int r = 0; r < 4; ++r) { red[(wave * 32 + fq * 4 + r) * 16 + fr] = c0[r]; red[(wave * 32 + 16 + fq * 4 + r) * 16 + fr] = c1[r]; }
        __syncthreads();
        if (tid < 64) {
            const int row = tid >> 1, c8 = (tid & 1) * 8;
            float va[8], vb[8];
#pragma unroll
            for (int e = 0; e < 8; ++e) { va[e] = 0.f; vb[e] = 0.f; }
#pragma unroll
            for (int w = 0; w < 4; ++w)
#pragma unroll
                for (int e = 0; e < 8; ++e) { va[e] += red[(w * 32 + row) * 16 + c8 + e]; vb[e] += red[((w + 4) * 32 + row) * 16 + c8 + e]; }
            f.apply2(MP + row, n0 + c8, va, vb);
        }
        __syncthreads();
    }
}

__device__ __forceinline__ void st8f(float* o, const float (&v)[8]) { *(f32x4*)o = (f32x4){v[0], v[1], v[2], v[3]}; *(f32x4*)(o + 4) = (f32x4){v[4], v[5], v[6], v[7]}; }
__device__ __forceinline__ void ld8f(const float* o, float (&v)[8]) { const f32x4 a = *(const f32x4*)o, b = *(const f32x4*)(o + 4); v[0] = a.x; v[1] = a.y; v[2] = a.z; v[3] = a.w; v[4] = b.x; v[5] = b.y; v[6] = b.z; v[7] = b.w; }

struct E1 {
    static constexpr bool ROWSUM = false;
    bf16* proj; const float* b_gate; float* out;
    __device__ __forceinline__ float apply(int row, int col, float (&v)[8]) const {
        if (col >= C_GATE) {
            float b[8]; ld8f(b_gate + (col - C_GATE), b);
#pragma unroll
            for (int e = 0; e < 8; ++e) v[e] = sigmoidf_(v[e] + b[e]);
        } else if (col >= C_GU) {
#pragma unroll
            for (int e = 0; e < 8; ++e) v[e] = gelu_tanh(v[e]);
        } else if (col >= C_V) {
            if (row < MP) { const int t = row & (SEQ - 1); if (t >= SEQ - 128) st8f(out + OFF_VP + ((size_t)((row >> 11) * 128 + (t - (SEQ - 128)))) * 256 + (col - C_V), v); }
            else st8f(out + OFF_VS + ((size_t)((row - MP) * 128 + 127)) * 256 + (col - C_V), v);
        }
        *(u32x4*)(proj + (size_t)row * N1 + col) = pack8(v);
        return 0.f;
    }
};
struct E2s {
    const bf16* proj; bf16* merged;
    __device__ __forceinline__ void apply2(int row, int col, float (&va)[8], float (&vb)[8]) const {
        float ga[8], gb[8]; unpack8(*(const u32x4*)(proj + (size_t)row * N1 + C_GATE + col), ga); unpack8(*(const u32x4*)(proj + (size_t)row * N1 + C_GATE + DM + col), gb);
#pragma unroll
        for (int e = 0; e < 8; ++e) va[e] = gb[e] * va[e] + ga[e] * vb[e];
        *(u32x4*)(merged + (size_t)row * DM + col) = pack8(va);
    }
};
struct E3 {
    static constexpr bool ROWSUM = true;
    const float *xp, *xs; float* y; const float* nw; bf16* xn; float* ss;
    __device__ __forceinline__ float apply(int row, int col, float (&v)[8]) const {
        const float* xr = row < MP ? xp + (size_t)row * DM : xs + (size_t)(row - MP) * DM;
        float x[8], w[8]; ld8f(xr + col, x); ld8f(nw + col, w);
        float q = 0.f;
#pragma unroll
        for (int e = 0; e < 8; ++e) { v[e] += x[e]; q += v[e] * v[e]; }
        st8f(y + (size_t)row * DM + col, v);
#pragma unroll
        for (int e = 0; e < 8; ++e) v[e] *= w[e];
        *(u32x4*)(xn + (size_t)row * DM + col) = pack8(v);
        return q;
    }
};
struct E4s {
    static constexpr bool ROWSUM = false;
    float* hs; float* out; const float* ss;
    __device__ __forceinline__ float apply(int row, int col, float (&v)[8]) const {
        const float rs = rsqrtf(ss[row] * (1.f / DM) + EPS);
#pragma unroll
        for (int e = 0; e < 8; ++e) v[e] *= rs;
        const int ch = (col >> 8) * 128 + (col & 127) + ((col & 128) ? DFF : 0);
        st8f(out + OFF_CS + ((size_t)((row - MP) * 2 + 1)) * NUP + ch, v);
        st8f(hs + (size_t)(row - MP) * NUP + col, v);
        return 0.f;
    }
};
template <int CTRL> __device__ __forceinline__ unsigned dppu(unsigned old, unsigned src) { return (unsigned)__builtin_amdgcn_update_dpp((int)old, (int)src, CTRL, 0xf, 0xf, false); }
template <int CTRL> __device__ __forceinline__ float dppf(float old, float src) {
    return __builtin_bit_cast(float, __builtin_amdgcn_update_dpp(__builtin_bit_cast(int, old), __builtin_bit_cast(int, src), CTRL, 0xf, 0xf, false));
}
struct EpiConv {
    static constexpr bool PERM = true, AFTER_DRAIN = false, MID = false;
    bf16* act; float* out; const float* ss; const float* cw; const float* cb; float* hb; LAS float* xb;
    __device__ __forceinline__ void operator()(const pg8::f32x4 (&acc)[2][2][4][2], const pg8::Unit& u, int, int, int, int) const {
        const int tid = tid_fresh(), wid = __builtin_amdgcn_readfirstlane(tid >> 6), lane = tid & 63, wr = wid >> 2, wc = wid & 3, fr = lane & 15, fq = lane >> 4;
        const int rowb = u.pm * 256 + wr * 64 + fr, cl = wc * 32 + 8 * fq, chg = u.pn * 128 + cl;
#define RS_(ai_, m_) __builtin_amdgcn_rsqf(ssl[(unsigned)(rowb + (ai_) * 128 + (m_) * 16)] * (1.f / DM) + EPS)
        const float* ssl = ss; asm volatile("" : "+s"(ssl));
        if (fr >= 14) {
#pragma unroll
            for (int ai = 0; ai < 2; ++ai) { LAS float* d = xb + ((ai * 2 + wr) * 2 + (fr - 14)) * 256 + cl; const float r3 = RS_(ai, 3);
#pragma unroll
                for (int bj = 0; bj < 2; ++bj) { *(LAS f32x4*)(d + bj * 128) = acc[ai][bj][3][0] * r3; *(LAS f32x4*)(d + bj * 128 + 4) = acc[ai][bj][3][1] * r3; } }
        }
        if (wr == 0 && fr < 2) { float* d = hb + (unsigned)((u.pm * 4 + fr) * NUP + u.pn * 256 + cl); const float r0 = RS_(0, 0);
#pragma unroll
            for (int bj = 0; bj < 2; ++bj) { *(f32x4*)(d + bj * 128) = acc[0][bj][0][0] * r0; *(f32x4*)(d + bj * 128 + 4) = acc[0][bj][0][1] * r0; } }
        if (wr == 1 && fr >= 14) { float* d = hb + (unsigned)((u.pm * 4 + 2 + fr - 14) * NUP + u.pn * 256 + cl); const float r3 = RS_(1, 3);
#pragma unroll
            for (int bj = 0; bj < 2; ++bj) { *(f32x4*)(d + bj * 128) = acc[1][bj][3][0] * r3; *(f32x4*)(d + bj * 128 + 4) = acc[1][bj][3][1] * r3; } }
        {
            LAS float* wl = xb + (WL_OFF - 131072) / 4; LAS float* rsl = xb + (RSL_OFF - 131072) / 4;
            const int idx = tid * 2, k = idx >> 8, c = idx & 255;
            const int chn = (c < 128) ? u.pn * 128 + c : DFF + u.pn * 128 + (c - 128);
            const float* src = (k < 3) ? cw + (unsigned)(k * NUP + chn) : cb + (unsigned)chn;
            const f32x2_t wv = *(const f32x2_t*)src;
            *(LAS f32x2_t*)(wl + idx) = wv;
            if (tid < 256) rsl[tid] = __builtin_amdgcn_rsqf(ssl[(unsigned)(u.pm * 256 + tid)] * (1.f / DM) + EPS);
        }
        __builtin_amdgcn_sched_barrier(0);
        asm volatile("s_waitcnt lgkmcnt(0)" ::: "memory");
        __builtin_amdgcn_s_barrier();
        const LAS float* wl = xb + (WL_OFF - 131072) / 4; const LAS float* rsl = xb + (RSL_OFF - 131072) / 4 + wr * 64 + fr;
#pragma unroll
        for (int ai = 0; ai < 2; ++ai)
#pragma unroll
            for (int m = 0; m < 4; ++m) {
                const int row = rowb + ai * 128 + m * 16, t = row & (SEQ - 1);
                const float rsc = rsl[ai * 128 + m * 16], rsp = rsl[ai * 128 + (m > 0 ? m - 1 : 0) * 16];
                unsigned opk[4];
#pragma unroll
                for (int n = 0; n < 2; ++n) {
                    float o[4];
#pragma unroll
                    for (int bj = 0; bj < 2; ++bj) {
                        const int ch = chg + bj * DFF;
                        const f32x4 cur = acc[ai][bj][m][n] * rsc;
                        f32x4 xp = {0.f, 0.f, 0.f, 0.f};
                        if (m > 0) xp = acc[ai][bj][m > 0 ? m - 1 : 0][n] * rsp;
                        else if (!(ai == 0 && wr == 0) && fr >= 14)
                            xp = *(const LAS f32x4*)(xb + ((wr == 1 ? (ai * 2 + 0) : ((ai - 1) * 2 + 1)) * 2 + (fr - 14)) * 256 + bj * 128 + cl + 4 * n);
                        const unsigned c01 = pk2m(cur[0], cur[1]), c23 = pk2m(cur[2], cur[3]), x01 = pk2m(xp[0], xp[1]), x23 = pk2m(xp[2], xp[3]);
                        unsigned a01 = dppu<0x111>(dppu<0x121>(0u, x01), c01), a23 = dppu<0x111>(dppu<0x121>(0u, x23), c23);
                        unsigned b01 = dppu<0x112>(dppu<0x122>(0u, x01), c01), b23 = dppu<0x112>(dppu<0x122>(0u, x23), c23);
                        if (t < 1) { a01 = 0u; a23 = 0u; }
                        if (t < 2) { b01 = 0u; b23 = 0u; }
                        const float p1[4] = {bf_lo(a01), bf_hi(a01), bf_lo(a23), bf_hi(a23)}, p2[4] = {bf_lo(b01), bf_hi(b01), bf_lo(b23), bf_hi(b23)};
                        const LAS float* wp = wl + bj * 128 + cl + 4 * n;
                        const f32x4 w0 = *(const LAS f32x4*)wp, w1 = *(const LAS f32x4*)(wp + 256), w2 = *(const LAS f32x4*)(wp + 512), bb = *(const LAS f32x4*)(wp + 768);
                        if (t >= SEQ - 2) *(f32x4*)(out + OFF_CP + (unsigned)(((row >> 11) * 2 + (t - (SEQ - 2))) * NUP + ch + 4 * n)) = cur;
#pragma unroll
                        for (int e = 0; e < 4; ++e) {
                            const float hc = w0[e] * p2[e] + w1[e] * p1[e] + w2[e] * cur[e] + bb[e];
                            if (bj == 0) o[e] = silu_(hc); else o[e] *= hc;
                        }
                    }
                    opk[2 * n] = pk2(o[0], o[1]); opk[2 * n + 1] = pk2(o[2], o[3]);
                }
                *(u32x4*)(act + (unsigned)(row * DFF + chg)) = (u32x4){opk[0], opk[1], opk[2], opk[3]};
                __builtin_amdgcn_sched_barrier(0);
            }
#undef RS_
    }
};
struct E5 {
    static constexpr bool ROWSUM = true;
    float* y; const float* nw; bf16* xn; float* ss;
    __device__ __forceinline__ float apply(int row, int col, float (&v)[8]) const {
        float x[8], w[8]; ld8f(y + (size_t)row * DM + col, x); ld8f(nw + col, w);
        float q = 0.f;
#pragma unroll
        for (int e = 0; e < 8; ++e) { v[e] += x[e]; q += v[e] * v[e]; }
        st8f(y + (size_t)row * DM + col, v);
#pragma unroll
        for (int e = 0; e < 8; ++e) v[e] *= w[e];
        *(u32x4*)(xn + (size_t)row * DM + col) = pack8(v);
        return q;
    }
};
struct E6a {
    static constexpr bool ROWSUM = false;
    bf16* pp;
    __device__ __forceinline__ float apply(int row, int col, float (&v)[8]) const { *(u32x4*)(pp + (size_t)row * DM + col) = pack8(v); return 0.f; }
};
struct E6b {
    static constexpr bool ROWSUM = false;
    const bf16* pp; float* y; const float* ss;
    __device__ __forceinline__ float apply(int row, int col, float (&v)[8]) const {
        const float rs = rsqrtf(ss[row] * (1.f / DM) + EPS);
        float x[8], q[8]; ld8f(y + (size_t)row * DM + col, x); unpack8(*(const u32x4*)(pp + (size_t)row * DM + col), q);
#pragma unroll
        for (int e = 0; e < 8; ++e) v[e] = x[e] + sigmoidf_(v[e] * rs) * q[e];
        st8f(y + (size_t)row * DM + col, v);
        return 0.f;
    }
};

struct TItem { const float* src; bf16* dst; int N, ldk; };
constexpr int I_IN = 32 * 112, I_GATE = 32 * 128, I_BA = 16 * 64, I_BG = 16 * 64, I_OUT = 32 * 64, I_UP = 32 * 352, I_DOWN = 88 * 64, I_PG = 32 * 64, I_PP = 4 * 64;
constexpr int NITEMS = I_IN + I_GATE + I_BA + I_BG + I_OUT + I_UP + I_DOWN + I_PG + I_PP, I_EARLY = I_IN + I_GATE + I_PP, I_MID = I_EARLY + I_BA + I_BG + I_OUT;
__device__ __forceinline__ TItem titem_mk(const float* W, int N, bf16* WT, int ldk, int item, bool upperm) {
    const int nblk = N / 32, kb = item / nblk, nb = item - kb * nblk, k0 = 64 * kb, n0 = 32 * nb;
    const int r0 = !upperm ? n0 : (n0 < DFF ? (n0 >> 7) * 256 + (n0 & 127) : ((n0 - DFF) >> 7) * 256 + 128 + ((n0 - DFF) & 127));
    TItem t; t.src = W + (size_t)k0 * N + n0; t.dst = WT + (size_t)r0 * ldk + k0; t.N = N; t.ldk = ldk; return t;
}
__device__ __forceinline__ TItem titem(KP p, int it) {
    unsigned char* ws = p->ws; int r = it;
    if (r < I_IN) return titem_mk(p->w_in, 3584, (bf16*)(ws + WS_W1), 2048, r, false); r -= I_IN;
    if (r < I_GATE) return titem_mk(p->w_gate, 4096, (bf16*)(ws + WS_W1) + (size_t)C_GATE * 2048, 2048, r, false); r -= I_GATE;
    if (r < I_PP) return titem_mk(p->w_ple_proj, 2048, (bf16*)(ws + WS_WPP), PLE, r, false); r -= I_PP;
    if (r < I_BA) return titem_mk(p->w_br_attn, 2048, (bf16*)(ws + WS_WBA), 2048, r, false); r -= I_BA;
    if (r < I_BG) return titem_mk(p->w_br_gm, 2048, (bf16*)(ws + WS_WBA) + 1024, 2048, r, false); r -= I_BG;
    if (r < I_OUT) return titem_mk(p->w_out, 2048, (bf16*)(ws + WS_WOUT), 2048, r, false); r -= I_OUT;
    if (r < I_UP) return titem_mk(p->w_up, NUP, (bf16*)(ws + WS_WUP), 2048, r, true); r -= I_UP;
    if (r < I_DOWN) return titem_mk(p->w_down, 2048, (bf16*)(ws + WS_WDOWN), DFF, r, false); r -= I_DOWN;
    return titem_mk(p->w_ple_gate, 2048, (bf16*)(ws + WS_WPG), 2048, r, false);
}
__device__ __forceinline__ void tload(const TItem& s, f32x4 (&t)[8], int lane) {
#pragma unroll
    for (int j = 0; j < 8; ++j) t[j] = __builtin_nontemporal_load((const f32x4*)(s.src + (size_t)((lane >> 3) + 8 * j) * s.N + (lane & 7) * 4));
}
__device__ __forceinline__ void tstore(const TItem& s, const f32x4 (&t)[8], LAS float* scr, int lane) {
#pragma unroll
    for (int j = 0; j < 8; ++j) { LAS float* d = scr + ((lane >> 3) + 8 * j) * 33 + (lane & 7) * 4; d[0] = t[j].x; d[1] = t[j].y; d[2] = t[j].z; d[3] = t[j].w; }
    asm volatile("s_waitcnt lgkmcnt(0)" ::: "memory");
    const int c = lane & 7;
#pragma unroll
    for (int j = 0; j < 4; ++j) { const int n = (lane >> 3) + 8 * j; const LAS float* q = scr + (8 * c) * 33 + n;
        u32x4 o; o.x = pk2(q[0 * 33], q[1 * 33]); o.y = pk2(q[2 * 33], q[3 * 33]); o.z = pk2(q[4 * 33], q[5 * 33]); o.w = pk2(q[6 * 33], q[7 * 33]);
        *(u32x4*)(s.dst + (size_t)n * s.ldk + 8 * c) = o; }
    asm volatile("s_waitcnt lgkmcnt(0)" ::: "memory");
}
__device__ __forceinline__ void convert_items(LAS unsigned char* lds, KP p, int lo, int hi, int w, int NW, int wave, int lane) {
    LAS float* scr = (LAS float*)(lds + wave * 16384);
    int it = lo + w; if (it >= hi) return;
    TItem cur = titem(p, it); f32x4 t[8]; tload(cur, t, lane);
    for (;;) {
        const int nx = it + NW; const bool has = nx < hi;
        TItem nxt = cur; f32x4 tn[8];
#pragma unroll
        for (int j = 0; j < 8; ++j) tn[j] = t[j];
        if (has) { nxt = titem(p, nx); tload(nxt, tn, lane); }
        tstore(cur, t, scr, lane);
        if (!has) break;
        cur = nxt; it = nx;
#pragma unroll
        for (int j = 0; j < 8; ++j) t[j] = tn[j];
    }
}
__device__ __forceinline__ void rms_row(const float* xrow, const float* w, bf16* orow, int lane) {
    f32x4 v[8]; float s = 0.f;
#pragma unroll
    for (int j = 0; j < 8; ++j) { v[j] = __builtin_nontemporal_load((const f32x4*)(xrow + lane * 4 + 256 * j)); s += (v[j].x * v[j].x + v[j].y * v[j].y) + (v[j].z * v[j].z + v[j].w * v[j].w); }
    const float rs = rsqrtf(wave_sum(s) * (1.f / DM) + EPS);
#pragma unroll
    for (int j = 0; j < 8; ++j) { const f32x4 ww = *(const f32x4*)(w + lane * 4 + 256 * j);
        u32x2 o; o.x = pk2(v[j].x * rs * ww.x, v[j].y * rs * ww.y); o.y = pk2(v[j].z * rs * ww.z, v[j].w * rs * ww.w);
        *(u32x2*)(orow + lane * 4 + 256 * j) = o; }
}
__device__ __forceinline__ void rms_phase(const float* src  , const float* w, bf16* dst) {
    const int tid = tid_fresh(), lane = tid & 63, gw = blockIdx.x * 8 + (tid >> 6), NGW = gridDim.x * 8;
    for (int m = gw; m < MALL; m += NGW) rms_row(src + (size_t)m * DM, w, dst + (size_t)m * DM, lane);
}

__device__ __forceinline__ void p0_phase(LAS unsigned char* lds, KP p) {
    const int tid = tid_fresh(), lane = tid & 63, wave = tid >> 6, gw = blockIdx.x * 8 + wave, NGW = gridDim.x * 8;
    unsigned char* ws = p->ws;
    convert_items(lds, p, 0, I_EARLY, blockIdx.x * 8 + __builtin_amdgcn_readfirstlane(wave), NGW, wave, lane);
    for (int i = blockIdx.x * 512 + tid; i < 32768; i += gridDim.x * 512) ((float*)ws)[i] = 0.f;
    bf16* XN = (bf16*)(ws + WS_XN); bf16* PBF = (bf16*)(ws + WS_PBF);
    for (int m = gw; m < MALL; m += NGW) {
        const float* xr = m < MP ? p->x_prompt + (size_t)m * DM : p->x_sample + (size_t)(m - MP) * DM;
        rms_row(xr, p->attn_norm_w, XN + (size_t)m * DM, lane);
        const float* pr = m < MP ? p->p_prompt + (size_t)m * PLE : p->p_sample + (size_t)(m - MP) * PLE;
        const f32x4 pv = *(const f32x4*)(pr + lane * 4);
        u32x2 o; o.x = pk2(pv.x, pv.y); o.y = pk2(pv.z, pv.w);
        *(u32x2*)(PBF + (size_t)m * PLE + lane * 4) = o;
    }
}

__device__ __forceinline__ void attn_prompt_unit(LAS unsigned char* lds, KP p, const bf16* proj, bf16* mix, int unit) {
    const int tid = tid_fresh(), wave = tid >> 6, lane = tid & 63, fr = lane & 15, fq = lane >> 4;
    const int kh = unit & 3, c = (unit >> 2) & 15, b = unit >> 6;
    LAS bf16* Ks = (LAS bf16*)lds;
    LAS bf16* Vt = (LAS bf16*)(lds + 36864);
#pragma unroll
    for (int i = 0; i < 4; ++i) {
        const int id = tid + 512 * i, j = id >> 3, ch = id & 7;
        const int pos = 128 * (c - 1) + j;
        u32x4 kraw = {0u, 0u, 0u, 0u}, vraw = {0u, 0u, 0u, 0u};
        if (pos >= 0) { const bf16* rp = proj + (size_t)(b * SEQ + pos) * N1; kraw = *(const u32x4*)(rp + C_K + kh * 64 + ch * 8); vraw = *(const u32x4*)(rp + C_V + kh * 64 + ch * 8); }
        float kf[8]; unpack8(kraw, kf);
        float ss = 0.f;
#pragma unroll
        for (int e = 0; e < 8; ++e) ss += kf[e] * kf[e];
        ss += __shfl_xor(ss, 1); ss += __shfl_xor(ss, 2); ss += __shfl_xor(ss, 4);
        const float rs = rsqrtf(ss * (1.f / 64.f) + EPS);
        float kw[8]; ld8f(p->k_norm_w + ch * 8, kw);
#pragma unroll
        for (int e = 0; e < 8; ++e) kf[e] = kf[e] * rs * kw[e];
        if (pos >= SEQ - 128) st8f(p->out + OFF_KP + ((size_t)((b * 128 + pos - (SEQ - 128)) * 4 + kh)) * 64 + ch * 8, kf);
        *(LAS u32x4*)(Ks + j * 72 + ch * 8) = pack8(kf);
        const unsigned vw[4] = {vraw.x, vraw.y, vraw.z, vraw.w};
#pragma unroll
        for (int e = 0; e < 8; ++e) Vt[(ch * 8 + e) * 264 + j] = (bf16)((e & 1) ? (vw[e >> 1] >> 16) : (vw[e >> 1] & 0xffffu));
    }
    __syncthreads();
    const int h = kh * 4 + (wave >> 1);
    const float slope = exp2f(-0.5f * (float)(h + 1)), sink = p->sinks[h];
    float qw0[8], qw1[8]; ld8f(p->q_norm_w + fq * 8, qw0); ld8f(p->q_norm_w + 32 + fq * 8, qw1);
    u32x4 qn0, qn1;
    { const bf16* qp = proj + (size_t)(b * SEQ + c * 128 + (wave & 1) * 64 + fr) * N1 + h * 64 + fq * 8; qn0 = *(const u32x4*)qp; qn1 = *(const u32x4*)(qp + 32); }
    for (int it = 0; it < 4; ++it) {
        int oz = 0; asm volatile("" : "+v"(oz));
        const LAS bf16* Ksi = Ks + oz; const LAS bf16* Vti = Vt + oz;
        const int qi = (wave & 1) * 64 + it * 16 + fr;
        const size_t qrow = (size_t)(b * SEQ + c * 128 + qi);
        float q0[8], q1[8]; unpack8(qn0, q0); unpack8(qn1, q1);
        { const int itn = it < 3 ? it + 1 : 3;
          const bf16* qp = proj + (size_t)(b * SEQ + c * 128 + (wave & 1) * 64 + itn * 16 + fr) * N1 + h * 64 + fq * 8; qn0 = *(const u32x4*)qp; qn1 = *(const u32x4*)(qp + 32); }
        float ss = 0.f;
#pragma unroll
        for (int e = 0; e < 8; ++e) ss += q0[e] * q0[e] + q1[e] * q1[e];
        ss += __shfl_xor(ss, 16); ss += __shfl_xor(ss, 32);
        const float rs = rsqrtf(ss * (1.f / 64.f) + EPS) * 0.125f;
#pragma unroll
        for (int e = 0; e < 8; ++e) { q0[e] = q0[e] * rs * qw0[e]; q1[e] = q1[e] * rs * qw1[e]; }
        const bf16x8 qb0 = __builtin_bit_cast(bf16x8, pack8m(q0)), qb1 = __builtin_bit_cast(bf16x8, pack8m(q1));
        f32x4 S[16];
#pragma unroll
        for (int T = 0; T < 16; ++T) {
            S[T] = (f32x4){0.f, 0.f, 0.f, 0.f};
            const LAS bf16* kp = Ksi + (T * 16 + fr) * 72 + fq * 8;
            S[T] = __builtin_amdgcn_mfma_f32_16x16x32_bf16(*(const LAS bf16x8*)kp, qb0, S[T], 0, 0, 0);
            S[T] = __builtin_amdgcn_mfma_f32_16x16x32_bf16(*(const LAS bf16x8*)(kp + 32), qb1, S[T], 0, 0, 0);
        }
        float mx = sink;
#pragma unroll
        for (int T = 0; T < 16; ++T)
#pragma unroll
            for (int r = 0; r < 4; ++r) {
                const int j = T * 16 + fq * 4 + r, dist = 128 + qi - j;
                const bool valid = (dist >= 0) && (dist <= 128) && (c > 0 || j >= 128);
                const float s = valid ? S[T][r] - slope * (float)dist : -1e30f;
                S[T][r] = s; mx = fmaxf(mx, s);
            }
        mx = fmaxf(mx, __shfl_xor(mx, 16)); mx = fmaxf(mx, __shfl_xor(mx, 32));
        float sum = 0.f;
#pragma unroll
        for (int T = 0; T < 16; ++T)
#pragma unroll
            for (int r = 0; r < 4; ++r) { const float pv = __expf(S[T][r] - mx); S[T][r] = pv; sum += pv; }
        sum += __shfl_xor(sum, 16); sum += __shfl_xor(sum, 32);
        sum += __expf(sink - mx);
        f32x4 O[4];
#pragma unroll
        for (int dt = 0; dt < 4; ++dt) O[dt] = (f32x4){0.f, 0.f, 0.f, 0.f};
#pragma unroll
        for (int s = 0; s < 8; ++s) {
            u32x4 pw; pw.x = pk2m(S[2 * s][0], S[2 * s][1]); pw.y = pk2m(S[2 * s][2], S[2 * s][3]); pw.z = pk2m(S[2 * s + 1][0], S[2 * s + 1][1]); pw.w = pk2m(S[2 * s + 1][2], S[2 * s + 1][3]);
            const bf16x8 pb = __builtin_bit_cast(bf16x8, pw);
#pragma unroll
            for (int dt = 0; dt < 4; ++dt) {
                const LAS bf16* vp = Vti + (dt * 16 + fr) * 264 + s * 32 + fq * 4;
                const u32x2 lo = *(const LAS u32x2*)vp, hi = *(const LAS u32x2*)(vp + 16);
                u32x4 vv; vv.x = lo.x; vv.y = lo.y; vv.z = hi.x; vv.w = hi.y;
                O[dt] = __builtin_amdgcn_mfma_f32_16x16x32_bf16(__builtin_bit_cast(bf16x8, vv), pb, O[dt], 0, 0, 0);
            }
        }
        const float inv = 1.f / sum;
#pragma unroll
        for (int dt = 0; dt < 4; ++dt) { u32x2 o; o.x = pk2(O[dt][0] * inv, O[dt][1] * inv); o.y = pk2(O[dt][2] * inv, O[dt][3] * inv);
            *(u32x2*)(mix + qrow * DM + h * 64 + dt * 16 + fq * 4) = o; }
    }
    __syncthreads();
}

__device__ __forceinline__ void sgu_prompt_unit(LAS unsigned char* lds, KP p, const bf16* proj, bf16* mix, int unit) {
    const int tid = tid_fresh(), wave = tid >> 6, lane = tid & 63, fr = lane & 15, fq = lane >> 4;
    const int g = unit & 3, c = (unit >> 2) & 15, b = unit >> 6;
    LAS bf16* vnT = (LAS bf16*)lds;
    LAS bf16* Wl = (LAS bf16*)(lds + 69632);
#pragma unroll
    for (int i = 0; i < 8; ++i) {
        const int id = tid + 512 * i, t = id >> 5, s4 = (id & 31) * 4;
        const f32x4 w = *(const f32x4*)(p->sgu_w + (size_t)(g * 128 + t) * 128 + s4);
        u32x2 o; o.x = pk2(s4 <= t ? w.x : 0.f, s4 + 1 <= t ? w.y : 0.f); o.y = pk2(s4 + 2 <= t ? w.z : 0.f, s4 + 3 <= t ? w.w : 0.f);
        *(LAS u32x2*)(Wl + t * 136 + s4) = o;
    }
    float nw[16];
    { float a[8], bq[8]; ld8f(p->sgu_norm_w + lane * 16, a); ld8f(p->sgu_norm_w + lane * 16 + 8, bq);
#pragma unroll
      for (int e = 0; e < 8; ++e) { nw[e] = a[e]; nw[8 + e] = bq[e]; } }
    for (int r8 = 0; r8 < 16; r8 += 8) {
        const int s0 = wave * 16 + r8;
        float x[8][16];
#pragma unroll
        for (int q = 0; q < 8; ++q) {
            const bf16* gp = proj + (size_t)(b * SEQ + c * 128 + s0 + q) * N1 + C_GV + lane * 16;
            const u32x4 ua = *(const u32x4*)gp, ub = *(const u32x4*)(gp + 8);
            float a[8], bq[8]; unpack8(ua, a); unpack8(ub, bq);
#pragma unroll
            for (int e = 0; e < 8; ++e) { x[q][e] = a[e]; x[q][8 + e] = bq[e]; }
        }
        float mean[8], rstd[8];
#pragma unroll
        for (int q = 0; q < 8; ++q) { float sm = 0.f;
#pragma unroll
            for (int e = 0; e < 16; ++e) sm += x[q][e];
            mean[q] = wave_sum(sm) * (1.f / 1024.f); }
#pragma unroll
        for (int q = 0; q < 8; ++q) { float sq = 0.f;
#pragma unroll
            for (int e = 0; e < 16; ++e) { x[q][e] -= mean[q]; sq += x[q][e] * x[q][e]; }
            rstd[q] = rsqrtf(wave_sum(sq) * (1.f / 1024.f) + EPS); }
        if (fq == g) {
#pragma unroll
            for (int q = 0; q < 8; ++q) {
#pragma unroll
                for (int e = 0; e < 16; ++e) x[q][e] = x[q][e] * rstd[q] * nw[e];
                if (c == 15) { float* o = p->out + OFF_GP + ((size_t)(b * 128 + s0 + q)) * 1024 + lane * 16;
#pragma unroll
                    for (int e4 = 0; e4 < 4; ++e4) *(f32x4*)(o + 4 * e4) = (f32x4){x[q][4 * e4], x[q][4 * e4 + 1], x[q][4 * e4 + 2], x[q][4 * e4 + 3]}; }
            }
#pragma unroll
            for (int e = 0; e < 16; ++e) {
                u32x4 w; w.x = pk2(x[0][e], x[1][e]); w.y = pk2(x[2][e], x[3][e]); w.z = pk2(x[4][e], x[5][e]); w.w = pk2(x[6][e], x[7][e]);
                *(LAS u32x4*)(vnT + (fr * 16 + e) * 136 + s0) = w;
            }
        }
    }
    __syncthreads();
    f32x4 acc[8][2];
#pragma unroll
    for (int tt = 0; tt < 8; ++tt) { acc[tt][0] = (f32x4){0.f, 0.f, 0.f, 0.f}; acc[tt][1] = (f32x4){0.f, 0.f, 0.f, 0.f}; }
#pragma unroll
    for (int ks = 0; ks < 4; ++ks) {
        const bf16x8 a0 = *(const LAS bf16x8*)(vnT + (wave * 32 + fr) * 136 + ks * 32 + fq * 8);
        const bf16x8 a1 = *(const LAS bf16x8*)(vnT + (wave * 32 + 16 + fr) * 136 + ks * 32 + fq * 8);
#pragma unroll
        for (int tt = 2 * ks; tt < 8; ++tt) {
            const bf16x8 bw = *(const LAS bf16x8*)(Wl + (tt * 16 + fr) * 136 + ks * 32 + fq * 8);
            acc[tt][0] = __builtin_amdgcn_mfma_f32_16x16x32_bf16(a0, bw, acc[tt][0], 0, 0, 0);
            acc[tt][1] = __builtin_amdgcn_mfma_f32_16x16x32_bf16(a1, bw, acc[tt][1], 0, 0, 0);
        }
    }
#pragma unroll
    for (int tt = 0; tt < 8; ++tt) {
        const int t = tt * 16 + fr; const size_t row = (size_t)(b * SEQ + c * 128 + t);
        const float bias = p->sgu_b[g * 128 + t];
#pragma unroll
        for (int ct = 0; ct < 2; ++ct) {
            const int ch = g * 256 + wave * 32 + ct * 16 + fq * 4;
            const u32x2 gu = *(const u32x2*)(proj + row * N1 + C_GU + ch);
            u32x2 o; o.x = pk2((acc[tt][ct][0] + bias) * bf_lo(gu.x), (acc[tt][ct][1] + bias) * bf_hi(gu.x));
            o.y = pk2((acc[tt][ct][2] + bias) * bf_lo(gu.y), (acc[tt][ct][3] + bias) * bf_hi(gu.y));
            *(u32x2*)(mix + row * DM + 1024 + ch) = o;
        }
    }
    __syncthreads();
}

__device__ __forceinline__ void sample_attn_item(LAS float* wl  , KP p, const bf16* proj, bf16* mix, int item, int lane) {
    const int h = item & 15, b = item >> 4, kh = h >> 2;
    const bf16* rp = proj + (size_t)(MP + b) * N1;
    float q = bf_lo((unsigned)rp[h * 64 + lane]), kn = bf_lo((unsigned)rp[C_K + kh * 64 + lane]), vn = bf_lo((unsigned)rp[C_V + kh * 64 + lane]);
    q = q * rsqrtf(wave_sum(q * q) * (1.f / 64.f) + EPS) * p->q_norm_w[lane] * 0.125f;
    kn = kn * rsqrtf(wave_sum(kn * kn) * (1.f / 64.f) + EPS) * p->k_norm_w[lane];
    const float slope = exp2f(-0.5f * (float)(h + 1)), sink = p->sinks[h];
    wl[lane] = q;
    asm volatile("s_waitcnt lgkmcnt(0)" ::: "memory");
    const float* kb = p->st_k + ((size_t)b * 128 * 4 + kh) * 64;
    float s0 = 0.f, s1 = 0.f;
    { const float* k0 = kb + (size_t)lane * 256; const float* k1 = kb + (size_t)(lane + 64) * 256;
#pragma unroll
      for (int d = 0; d < 64; d += 4) { const f32x4 a = *(const f32x4*)(k0 + d), c4 = *(const f32x4*)(k1 + d);
          const float w0 = wl[d], w1 = wl[d + 1], w2 = wl[d + 2], w3 = wl[d + 3];
          s0 += a.x * w0 + a.y * w1 + a.z * w2 + a.w * w3; s1 += c4.x * w0 + c4.y * w1 + c4.z * w2 + c4.w * w3; } }
    const float* vb = p->st_v + ((size_t)b * 128 * 4 + kh) * 64 + lane;
    float vv[128];
#pragma unroll
    for (int j = 0; j < 128; ++j) vv[j] = vb[(size_t)j * 256];
    s0 -= slope * (float)(128 - lane); s1 -= slope * (float)(64 - lane);
    const float sn = wave_sum(q * kn);
    const float mx = fmaxf(fmaxf(wave_max(fmaxf(s0, s1)), sn), sink);
    const float p0 = __expf(s0 - mx), p1 = __expf(s1 - mx), pn = __expf(sn - mx);
    const float den = wave_sum(p0 + p1) + pn + __expf(sink - mx);
    wl[64 + lane] = p0; wl[128 + lane] = p1;
    asm volatile("s_waitcnt lgkmcnt(0)" ::: "memory");
    float o = pn * vn;
#pragma unroll
    for (int j = 0; j < 128; ++j) o += wl[64 + j] * vv[j];
    mix[(size_t)(MP + b) * DM + h * 64 + lane] = (bf16)(pk2(o / den, 0.f) & 0xffffu);
    if ((h & 3) == 0) p->out[OFF_KS + ((size_t)(b * 128 + 127) * 4 + kh) * 64 + lane] = kn;
    asm volatile("s_waitcnt lgkmcnt(0)" ::: "memory");
}
__device__ __forceinline__ void sample_sgu_item(KP p, const bf16* proj, bf16* mix, int b, int lane) {
    const bf16* rp = proj + (size_t)(MP + b) * N1;
    float x[16];
    { float a[8], bq[8]; unpack8(*(const u32x4*)(rp + C_GV + lane * 16), a); unpack8(*(const u32x4*)(rp + C_GV + lane * 16 + 8), bq);
#pragma unroll
      for (int e = 0; e < 8; ++e) { x[e] = a[e]; x[8 + e] = bq[e]; } }
    float sm = 0.f;
#pragma unroll
    for (int e = 0; e < 16; ++e) sm += x[e];
    const float mean = wave_sum(sm) * (1.f / 1024.f);
    float sq = 0.f;
#pragma unroll
    for (int e = 0; e < 16; ++e) { x[e] -= mean; sq += x[e] * x[e]; }
    const float rstd = rsqrtf(wave_sum(sq) * (1.f / 1024.f) + EPS);
    const int g = lane >> 4;
    const float w00 = p->sgu_w[(size_t)g * 128 * 128], b0 = p->sgu_b[g * 128];
    float gu[16];
    { float a[8], bq[8]; unpack8(*(const u32x4*)(rp + C_GU + lane * 16), a); unpack8(*(const u32x4*)(rp + C_GU + lane * 16 + 8), bq);
#pragma unroll
      for (int e = 0; e < 8; ++e) { gu[e] = a[e]; gu[8 + e] = bq[e]; } }
    float o8[8], o9[8];
#pragma unroll
    for (int e = 0; e < 16; ++e) {
        const float vn = x[e] * rstd * p->sgu_norm_w[lane * 16 + e];
        p->out[OFF_GS + (size_t)b * 1024 + lane * 16 + e] = vn;
        const float r = gu[e] * (w00 * vn + b0);
        if (e < 8) o8[e] = r; else o9[e - 8] = r;
    }
    *(u32x4*)(mix + (size_t)(MP + b) * DM + 1024 + lane * 16) = pack8(o8);
    *(u32x4*)(mix + (size_t)(MP + b) * DM + 1024 + lane * 16 + 8) = pack8(o9);
}

__device__ __forceinline__ void p2_phase(LAS unsigned char* lds, KP p, const bf16* proj, bf16* mix) {
    const int G = gridDim.x;
    for (int u = blockIdx.x; u < 256; u += G) attn_prompt_unit(lds, p, proj, mix, u);
    for (int u = blockIdx.x; u < 256; u += G) sgu_prompt_unit(lds, p, proj, mix, u);
    const int tid = tid_fresh(), lane = tid & 63, wave = tid >> 6, gw = blockIdx.x * 8 + wave, NGW = G * 8;
    LAS float* wl = (LAS float*)lds + wave * 256;
    for (int it = gw; it < 512 + 32; it += NGW) {
        if (it < 512) sample_attn_item(wl, p, proj, mix, it, lane);
        else sample_sgu_item(p, proj, mix, it - 512, lane);
    }
    for (int idx = blockIdx.x * 512 + tid; idx < MS * 127 * 64; idx += G * 512) {
        const int bb = idx / (127 * 64), rem = idx - bb * (127 * 64), j = rem >> 6, c4 = (rem & 63) * 4;
        const size_t src = ((size_t)(bb * 128 + j + 1)) * 256 + c4, dst = ((size_t)(bb * 128 + j)) * 256 + c4;
        *(f32x4*)(p->out + OFF_KS + dst) = *(const f32x4*)(p->st_k + src);
        *(f32x4*)(p->out + OFF_VS + dst) = *(const f32x4*)(p->st_v + src);
    }
    __syncthreads();
    {
        constexpr int FIRST = (512 + MS + 7) / 8;
        const int f = ((int)gridDim.x > 2 * FIRST) ? FIRST : 0;
        if ((int)blockIdx.x >= f) convert_items(lds, p, I_EARLY, I_MID, ((int)blockIdx.x - f) * 8 + __builtin_amdgcn_readfirstlane(wave), ((int)gridDim.x - f) * 8, __builtin_amdgcn_readfirstlane(wave), lane);
    }
    __syncthreads();
}

__device__ __forceinline__ void conv_fix_phase(KP p, const float* hb, const float* hs, bf16* act) {
    const int NT = gridDim.x * 512;
    constexpr int NCG = DFF / 8, NPR = 28 * 2;
    for (int it = blockIdx.x * 512 + tid_fresh(); it < NCG * (NPR + MS); it += NT) {
        const int cgp = it % NCG, ri = it / NCG, ch = cgp * 8, colg = (ch >> 7) * 256 + (ch & 127), colu = colg + 128;
        float wg0[8], wg1[8], wg2[8], bg[8], wu0[8], wu1[8], wu2[8], bu[8];
        ld8f(p->conv_w + ch, wg0); ld8f(p->conv_w + NUP + ch, wg1); ld8f(p->conv_w + 2 * NUP + ch, wg2); ld8f(p->conv_b + ch, bg);
        ld8f(p->conv_w + DFF + ch, wu0); ld8f(p->conv_w + NUP + DFF + ch, wu1); ld8f(p->conv_w + 2 * NUP + DFF + ch, wu2); ld8f(p->conv_b + DFF + ch, bu);
        float g2[8], g1[8], g0[8], u2[8], u1[8], u0[8], o[8];
        size_t orow;
        if (ri < NPR) {
            const int k = ri >> 1, rr = ri & 1, pm = (k / 7) * 8 + (k % 7) + 1;
            const float* h2 = rr == 0 ? hb + ((size_t)((pm - 1) * 4 + 2)) * NUP : hb + ((size_t)((pm - 1) * 4 + 3)) * NUP;
            const float* h1 = rr == 0 ? hb + ((size_t)((pm - 1) * 4 + 3)) * NUP : hb + ((size_t)(pm * 4 + 0)) * NUP;
            const float* h0 = hb + ((size_t)(pm * 4 + rr)) * NUP;
            ld8f(h2 + colg, g2); ld8f(h1 + colg, g1); ld8f(h0 + colg, g0); ld8f(h2 + colu, u2); ld8f(h1 + colu, u1); ld8f(h0 + colu, u0);
            orow = (size_t)pm * 256 + rr;
        } else {
            const int bb = ri - NPR;
            const float* st = p->st_conv + (size_t)bb * 2 * NUP;
            ld8f(st + ch, g2); ld8f(st + NUP + ch, g1); ld8f(st + DFF + ch, u2); ld8f(st + NUP + DFF + ch, u1);
            ld8f(hs + (size_t)bb * NUP + colg, g0); ld8f(hs + (size_t)bb * NUP + colu, u0);
            st8f(p->out + OFF_CS + (size_t)bb * 2 * NUP + ch, g1); st8f(p->out + OFF_CS + (size_t)bb * 2 * NUP + DFF + ch, u1);
            orow = (size_t)MP + bb;
        }
#pragma unroll
        for (int e = 0; e < 8; ++e) {
            const float hg = wg0[e] * g2[e] + wg1[e] * g1[e] + wg2[e] * g0[e] + bg[e];
            const float hu = wu0[e] * u2[e] + wu1[e] * u1[e] + wu2[e] * u0[e] + bu[e];
            o[e] = silu_(hg) * hu;
        }
        *(u32x4*)(act + orow * DFF + ch) = pack8(o);
    }
}

__device__ __forceinline__ void bubble_convert(LAS unsigned char* lds, KP p, int first, int lo, int hi) {
    if ((int)blockIdx.x < first) return;
    const int tid = tid_fresh(), lane = tid & 63, wave = __builtin_amdgcn_readfirstlane(tid >> 6);
    convert_items(lds, p, lo, hi, ((int)blockIdx.x - first) * 8 + wave, ((int)gridDim.x - first) * 8, wave, lane);
    __syncthreads();
}
#define XB_TMO      128
#define XB_XCNT(j)  (256  + 64 * (j))
#define XB_XSUB(j)  (1280 + 64 * (j))
#define XB_XGEN(j)  (2304 + 64 * (j))
#define XB_TOP      3328
#define XB_TOPGEN   3392
#define XCD_BAR_WORDS 3456
#define XB_SPIN_CAP (1u << 18)

__device__ __forceinline__ unsigned xb_ld(unsigned* p)              { return __hip_atomic_load(p, __ATOMIC_RELAXED, __HIP_MEMORY_SCOPE_AGENT); }
__device__ __forceinline__ unsigned xb_add(unsigned* p, unsigned v) { return __hip_atomic_fetch_add(p, v, __ATOMIC_RELAXED, __HIP_MEMORY_SCOPE_AGENT); }
__device__ __forceinline__ unsigned xb_xcc_id() { return (unsigned)__builtin_amdgcn_s_getreg((3 << 11) | 20) & 0xFu; }
#define XB_SPIN(cond, bar) do { unsigned _sp = 0; while (cond) { __builtin_amdgcn_s_sleep(1); \
    if ((++_sp & 255u) == 0u) { if (xb_ld(&(bar)[XB_TMO])) break; if (_sp > XB_SPIN_CAP) { atomicAdd(&(bar)[XB_TMO], 1u); break; } } } } while (0)

struct XcdBarrier {
    unsigned* bar; unsigned x;
    volatile LAS unsigned* st;
};

__device__ __forceinline__ XcdBarrier xcd_barrier_post(unsigned* bar, volatile LAS unsigned* st) {
    XcdBarrier b; b.bar = bar; b.x = xb_xcc_id(); b.st = st;
    if (threadIdx.x == 0) (void)xb_add(&bar[XB_XCNT(b.x)], 1u);
    return b;
}
__device__ __forceinline__ void xcd_barrier_complete(unsigned* bar, unsigned x, unsigned& nloc, unsigned& nx) {
    const unsigned G = gridDim.x * gridDim.y * gridDim.z;
    unsigned sum, cnt, mine, sp = 0u;
    for (;;) {
        sum = 0u; cnt = 0u; mine = 0u;
#pragma unroll
        for (unsigned j = 0; j < 16; ++j) { const unsigned c = xb_ld(&bar[XB_XCNT(j)]); sum += c; cnt += (c > 0u) ? 1u : 0u; mine = (j == x) ? c : mine; }
        if (sum == G) break;
        __builtin_amdgcn_s_sleep(1);
        if ((++sp & 255u) == 0u) { if (xb_ld(&bar[XB_TMO])) break; if (sp > XB_SPIN_CAP) { atomicAdd(&bar[XB_TMO], 1u); break; } }
    }
    nloc = mine > 0u ? mine : 1u; nx = cnt > 0u ? cnt : 1u;
}

__device__ __forceinline__ void xcd_barrier(const XcdBarrier& b) {
    asm volatile("s_waitcnt vmcnt(0)" ::: "memory");
    __syncthreads();
    if (threadIdx.x == 0) {
        unsigned* bar = b.bar;
        __builtin_amdgcn_s_waitcnt(0);
        unsigned nloc = b.st[0], nx = b.st[1];
        if (nloc == 0u) { xcd_barrier_complete(bar, b.x, nloc, nx); b.st[0] = nloc; b.st[1] = nx; }
        const unsigned old = xb_add(&bar[XB_XSUB(b.x)], 1u);
        const unsigned gen = old / nloc;
        if (old + 1u == (gen + 1u) * nloc) {
            __builtin_amdgcn_fence(__ATOMIC_RELEASE, "agent");
            asm volatile("s_waitcnt vmcnt(0)" ::: "memory");
            const unsigned og = xb_add(&bar[XB_TOP], 1u);
            const unsigned tg = og / nx;
            if (og + 1u == (tg + 1u) * nx) xb_add(&bar[XB_TOPGEN], 1u);
            else XB_SPIN(xb_ld(&bar[XB_TOPGEN]) == tg, bar);
            __builtin_amdgcn_fence(__ATOMIC_ACQUIRE, "agent");
            xb_add(&bar[XB_XGEN(b.x)], 1u);
            asm volatile("s_waitcnt vmcnt(0)" ::: "memory");
        } else {
            XB_SPIN(xb_ld(&bar[XB_XGEN(b.x)]) == gen, bar);
            __builtin_amdgcn_fence(__ATOMIC_ACQUIRE, "agent");
            asm volatile("s_waitcnt vmcnt(0)" ::: "memory");
        }
    }
    __syncthreads();
}


__global__ void __launch_bounds__(512, 2) fwd_mega(Params p_unused) {
    extern __shared__ __attribute__((aligned(16))) unsigned char lds_raw[];
    LAS unsigned char* lds = (LAS unsigned char*)lds_raw;
    cg::grid_group grid = cg::this_grid();
    if (threadIdx.x < 64) ((LAS unsigned*)(lds + MISC_OFF))[threadIdx.x] = 0u;
    __syncthreads();
    if (gridDim.x > 65535u) grid.sync();
    { KP p = kargs(); (void)xcd_barrier_post((unsigned*)(p->ws + WS_BAR), (volatile LAS unsigned*)(lds + MISC_OFF)); }
#define WSP(T, off) ((T*)(ws + (off)))
#define XSYNC() do { KP p_ = kargs(); XcdBarrier b_; b_.bar = (unsigned*)(p_->ws + WS_BAR); b_.x = xb_xcc_id(); b_.st = (volatile LAS unsigned*)(lds + MISC_OFF); xcd_barrier(b_); } while (0)
#define REP(k) for (int rep_ = 0; rep_ < ((DUP_PHASE == (k)) ? 2 : 1); ++rep_)
    REP(0) { KP p = kargs(); p0_phase(lds, p); }
    XSYNC();
    REP(1) { KP p = kargs(); unsigned char* ws = p->ws; E1 e{WSP(bf16, WS_PROJ), p->b_gate, p->out};
      big_gemm(lds, WSP(bf16, WS_XN), DM, WSP(bf16, WS_W1), DM, N1, DM, e); small_gemm(lds, WSP(bf16, WS_XN) + (size_t)MP * DM, DM, WSP(bf16, WS_W1), DM, N1, DM, e);
      bubble_convert(lds, p, (MP / 256 * (N1 / 256)) % (int)gridDim.x, I_MID, I_MID + I_UP); }
    XSYNC();
    REP(2) { KP p = kargs(); unsigned char* ws = p->ws; p2_phase(lds, p, WSP(bf16, WS_PROJ), WSP(bf16, WS_MIX)); }
    XSYNC();
    { KP p = kargs(); unsigned char* ws = p->ws;
      EpiMerge em{WSP(bf16, WS_PROJ), WSP(bf16, WS_MERGED)};
      pg8::Gemm g{WSP(bf16, WS_MIX), WSP(bf16, WS_WBA), MP, DM, DM, DM, DM}; pg8::StaticOrder S; S.init(MP, DM, (int)gridDim.x, (int)blockIdx.x);
      pg8::gemm_phase<EpiMerge, pg8::StaticOrder, true, true>(lds, g, S, em);
      E2s es{WSP(bf16, WS_PROJ), WSP(bf16, WS_MERGED)};
      small_gemm_dual(lds, WSP(bf16, WS_MIX) + (size_t)MP * DM, DM, WSP(bf16, WS_WBA), DM, DM, es); }
    XSYNC();
    REP(4) { KP p = kargs(); unsigned char* ws = p->ws; E3 e{p->x_prompt, p->x_sample, p->out + OFF_Y, p->ffn_norm_w, WSP(bf16, WS_XN), WSP(float, WS_SS1)};
      big_gemm(lds, WSP(bf16, WS_MERGED), DM, WSP(bf16, WS_WOUT), DM, DM, DM, e); small_gemm(lds, WSP(bf16, WS_MERGED) + (size_t)MP * DM, DM, WSP(bf16, WS_WOUT), DM, DM, DM, e); }
    XSYNC();
    { KP p = kargs(); unsigned char* ws = p->ws;
      EpiConv ec{WSP(bf16, WS_ACT), p->out, WSP(float, WS_SS1), p->conv_w, p->conv_b, WSP(float, WS_HB), (LAS float*)(lds + 131072)};
      pg8::Gemm g{WSP(bf16, WS_XN), WSP(bf16, WS_WUP), MP, NUP, DM, DM, DM}; pg8::StaticOrder S; S.init(MP, NUP, (int)gridDim.x, (int)blockIdx.x);
      pg8::gemm_phase<EpiConv, pg8::StaticOrder, true, true>(lds, g, S, ec);
      E4s e{WSP(float, WS_HS), p->out, WSP(float, WS_SS1)};
      small_gemm(lds, WSP(bf16, WS_XN) + (size_t)MP * DM, DM, WSP(bf16, WS_WUP), DM, NUP, DM, e);
      const int first6 = (MP / 256 * (NUP / 256)) % (int)gridDim.x;
      bubble_convert(lds, p, first6, I_MID + I_UP, NITEMS);
      if ((int)blockIdx.x >= first6) {
          E6a e6{WSP(bf16, WS_PP)}; EpiAd<E6a> E{e6};
          pg8::Gemm g2{WSP(bf16, WS_PBF), WSP(bf16, WS_WPP), MP, DM, PLE, PLE, PLE}; pg8::StaticOrder S2; S2.init(MP, DM, (int)gridDim.x - first6, (int)blockIdx.x - first6);
          pg8::gemm_phase<EpiAd<E6a>, pg8::StaticOrder, true, true>(lds, g2, S2, E);
      }
      { E6a e6{WSP(bf16, WS_PP)}; small_gemm(lds, WSP(bf16, WS_PBF) + (size_t)MP * PLE, PLE, WSP(bf16, WS_WPP), PLE, DM, PLE, e6); } }
    XSYNC();
    { KP p = kargs(); unsigned char* ws = p->ws; conv_fix_phase(p, WSP(float, WS_HB), WSP(float, WS_HS), WSP(bf16, WS_ACT)); }
    XSYNC();
    { KP p = kargs(); unsigned char* ws = p->ws; E5 e{p->out + OFF_Y, p->ple_norm_w, WSP(bf16, WS_XN3), WSP(float, WS_SS2)};
      big_gemm(lds, WSP(bf16, WS_ACT), DFF, WSP(bf16, WS_WDOWN), DFF, DM, DFF, e); small_gemm(lds, WSP(bf16, WS_ACT) + (size_t)MP * DFF, DFF, WSP(bf16, WS_WDOWN), DFF, DM, DFF, e); }
    XSYNC();
    { KP p = kargs(); unsigned char* ws = p->ws; E6b e{WSP(bf16, WS_PP), p->out + OFF_Y, WSP(float, WS_SS2)};
      big_gemm(lds, WSP(bf16, WS_XN3), DM, WSP(bf16, WS_WPG), DM, DM, DM, e); small_gemm(lds, WSP(bf16, WS_XN3) + (size_t)MP * DM, DM, WSP(bf16, WS_WPG), DM, DM, DM, e); }
#undef WSP
}

extern "C" void kernel_launch(void* const* d_in, const int* in_sizes, int n_in, void* d_out, int out_size, void* d_ws, size_t ws_size, hipStream_t stream) {
    static int grid = 0;
    if (grid == 0) {
        if (n_in != 28 || out_size != (int)OUT_TOTAL || ws_size < WS_END) { fprintf(stderr, "kernel_launch: unexpected shapes: n_in %d out %d ws %zu\n", n_in, out_size, ws_size); grid = -1; return; }
        int dev = 0, cus = 0, per_cu = 0;
        (void)hipGetDevice(&dev); (void)hipDeviceGetAttribute(&cus, hipDeviceAttributeMultiprocessorCount, dev);
        if (hipFuncSetAttribute((const void*)fwd_mega, hipFuncAttributeMaxDynamicSharedMemorySize, LDS_BYTES) != hipSuccess) { fprintf(stderr, "kernel_launch: hipFuncSetAttribute failed\n"); grid = -1; return; }
        if (hipOccupancyMaxActiveBlocksPerMultiprocessor(&per_cu, (const void*)fwd_mega, 512, LDS_BYTES) != hipSuccess || per_cu < 1) { fprintf(stderr, "kernel_launch: occupancy query says %d\n", per_cu); per_cu = 1; }
        (void)hipGetLastError();
        grid = cus * 1;
    }
    if (grid < 0) return;
    Params p{};
    const float** pp = (const float**)&p;
    for (int i = 0; i < 28; ++i) pp[i] = (const float*)d_in[i];
    p.out = (float*)d_out; p.ws = (unsigned char*)d_ws;
    if (hipMemsetAsync((char*)d_ws + WS_BAR, 0, XCD_BAR_WORDS * 4, stream) != hipSuccess) { fprintf(stderr, "kernel_launch: memset of the barrier words failed\n"); return; }
    void* args[] = {&p};
    hipError_t e = hipLaunchCooperativeKernel((const void*)fwd_mega, dim3(grid), dim3(512), args, LDS_BYTES, stream);
    if (e != hipSuccess) fprintf(stderr, "kernel_launch: cooperative launch failed: %s (grid %d)\n", hipGetErrorString(e), grid);
}
```

```cpp
#include <hip/hip_runtime.h>
#include <hip/hip_cooperative_groups.h>
#include <cstdio>
#include <cstdint>
namespace cg = cooperative_groups;

#define LAS __attribute__((address_space(3)))
typedef unsigned short bf16;
typedef unsigned u32x4 __attribute__((ext_vector_type(4)));
typedef unsigned u32x2 __attribute__((ext_vector_type(2)));
typedef float f32x4 __attribute__((ext_vector_type(4)));
typedef short bf16x8 __attribute__((ext_vector_type(8)));

constexpr int DM = 2048, MP = 8192, MS = 32, MALL = MP + MS, SEQ = 2048;
constexpr int N1 = 7680, DFF = 5632, NUP = 11264, PLE = 256;
constexpr int C_K = 1024, C_V = 1280, C_GU = 1536, C_GV = 2560, C_GATE = 3584;
constexpr float EPS = 1e-6f;
constexpr size_t OFF_Y = 0, OFF_KP = 16842752, OFF_VP = 16973824, OFF_KS = 17104896, OFF_VS = 18153472,
                 OFF_GP = 19202048, OFF_GS = 19726336, OFF_CP = 19759104, OFF_CS = 19849216, OUT_TOTAL = 20570112;
constexpr size_t MiB = 1u << 20;
constexpr size_t WS_WUP = 1 * MiB, WS_WDOWN = 45 * MiB, WS_WPG = 67 * MiB, WS_WPP = 75 * MiB, WS_XN = 76 * MiB;
constexpr size_t WS_W1 = 109 * MiB, WS_WBA = 139 * MiB, WS_WBG = 143 * MiB, WS_WOUT = 147 * MiB;
constexpr size_t WS_PROJ = 155 * MiB, WS_MIX = 276 * MiB, WS_MERGED = 309 * MiB, WS_PBF = 342 * MiB;
constexpr size_t WS_BAR = 262144;
constexpr size_t WS_SS1 = 0, WS_SS2 = 65536, WS_XN3 = 254 * MiB, WS_HB = 109 * MiB, WS_HS = 116 * MiB;
constexpr size_t WS_ACT = 165 * MiB, WS_PP = 118 * MiB, WS_END = 347 * MiB;
static_assert(WS_PROJ + (size_t)MALL * N1 * 2 <= WS_MIX && WS_MIX + (size_t)MALL * 2048 * 2 <= WS_MERGED && WS_MERGED + (size_t)MALL * 2048 * 2 <= WS_PBF, "ws map early");
static_assert(WS_ACT + (size_t)MALL * DFF * 2 <= WS_XN3 && WS_XN3 + (size_t)MALL * DM * 2 <= WS_PBF && WS_PBF + (size_t)MALL * PLE * 2 <= WS_END && WS_PP + (size_t)MALL * DM * 2 <= WS_ACT && WS_HS + (size_t)MS * NUP * 4 <= WS_PP && WS_HB + (size_t)32 * 4 * NUP * 4 <= WS_HS && WS_HS + (size_t)MS * NUP * 4 <= WS_ACT, "ws map late");
constexpr int MISC_OFF = 131072 + 8192;
constexpr int WL_OFF = 131072 + 8192 + 256, RSL_OFF = WL_OFF + 4096;
constexpr int LDS_BYTES = RSL_OFF + 1024;
#ifndef DUP_PHASE
#define DUP_PHASE -1
#endif

struct Params {
    const float *x_prompt, *x_sample, *p_prompt, *p_sample, *st_k, *st_v, *st_conv;
    const float *attn_norm_w, *w_in, *q_norm_w, *k_norm_w, *sinks, *sgu_norm_w, *sgu_w, *sgu_b;
    const float *w_br_attn, *w_br_gm, *w_gate, *b_gate, *w_out, *ffn_norm_w, *w_up, *conv_w, *conv_b, *w_down, *ple_norm_w, *w_ple_gate, *w_ple_proj;
    float* out; unsigned char* ws;
};

typedef const __attribute__((address_space(4))) Params* KP;
__device__ __forceinline__ KP kargs() { KP k = (KP)__builtin_amdgcn_kernarg_segment_ptr(); asm volatile("" : "+s"(k)); return k; }

__device__ __forceinline__ int tid_fresh() { int t = threadIdx.x; asm volatile("" : "+v"(t)); return t; }
typedef float f32x2_t __attribute__((ext_vector_type(2)));
typedef __bf16 bf16x2_t __attribute__((ext_vector_type(2)));
__device__ __forceinline__ unsigned pk2m(float lo, float hi) { f32x2_t v = {lo, hi}; bf16x2_t b = __builtin_convertvector(v, bf16x2_t); return __builtin_bit_cast(unsigned, b); }
__device__ __forceinline__ unsigned pk2(float lo, float hi) { unsigned r; asm("v_cvt_pk_bf16_f32 %0, %1, %2" : "=v"(r) : "v"(lo), "v"(hi)); return r; }
__device__ __forceinline__ float bf_lo(unsigned u) { return __builtin_bit_cast(float, u << 16); }
__device__ __forceinline__ float bf_hi(unsigned u) { return __builtin_bit_cast(float, u & 0xffff0000u); }
__device__ __forceinline__ void unpack8(const u32x4 u, float (&f)[8]) {
    f[0] = bf_lo(u.x); f[1] = bf_hi(u.x); f[2] = bf_lo(u.y); f[3] = bf_hi(u.y); f[4] = bf_lo(u.z); f[5] = bf_hi(u.z); f[6] = bf_lo(u.w); f[7] = bf_hi(u.w);
}
__device__ __forceinline__ u32x4 pack8m(const float (&f)[8]) { u32x4 u; u.x = pk2m(f[0], f[1]); u.y = pk2m(f[2], f[3]); u.z = pk2m(f[4], f[5]); u.w = pk2m(f[6], f[7]); return u; }
__device__ __forceinline__ u32x4 pack8(const float (&f)[8]) { u32x4 u; u.x = pk2(f[0], f[1]); u.y = pk2(f[2], f[3]); u.z = pk2(f[4], f[5]); u.w = pk2(f[6], f[7]); return u; }
__device__ __forceinline__ float wave_sum(float v) {
#pragma unroll
    for (int o = 1; o < 64; o <<= 1) v += __shfl_xor(v, o);
    return v;
}
__device__ __forceinline__ float wave_max(float v) {
#pragma unroll
    for (int o = 1; o < 64; o <<= 1) v = fmaxf(v, __shfl_xor(v, o));
    return v;
}
__device__ __forceinline__ float sigmoidf_(float z) { return __builtin_amdgcn_rcpf(1.f + __expf(-z)); }
__device__ __forceinline__ float gelu_tanh(float x) { const float u = 0.7978845608028654f * (x + 0.044715f * x * x * x); return x * __builtin_amdgcn_rcpf(1.f + __expf(-2.f * u)); }
__device__ __forceinline__ float silu_(float x) { return x * __builtin_amdgcn_rcpf(1.f + __expf(-x)); }

namespace pg8 {
#define PG8_LAS __attribute__((address_space(3)))
typedef unsigned short bf16_t;
typedef short bf16x8 __attribute__((ext_vector_type(8)));
typedef float f32x4 __attribute__((ext_vector_type(4)));
constexpr int BM = 256, BK = 64, HALF = 128, HTB = HALF * BK * 2, STAGE_BYTES = 8 * HTB, NXCD = 8, WGM = 8;

__host__ __device__ __forceinline__ int lds_byte(int r, int c) { const int st = (r >> 4) * 2 + (c >> 5), rr = r & 15, cc = c & 31, ob = rr * 64 + cc * 2; return st * 1024 + (ob ^ (((ob >> 9) & 1) << 5)); }
__host__ __device__ __forceinline__ void stage_rc(int b, int& R, int& C) { const int st = b / 1024, sb = b % 1024, swz = sb ^ (((sb >> 9) & 1) << 5); R = (st >> 1) * 16 + swz / 64; C = (st & 1) * 32 + (swz % 64) / 2; }
__host__ __device__ __forceinline__ int perm32(int rho) { const int n = rho >> 4, i = rho & 15; return 8 * (i >> 2) + 4 * n + (i & 3); }

struct Unit { int pm, pn; };
struct Gemm { const bf16_t* A; const bf16_t* Bt; int M, N, K, lda, ldb; };

struct StaticOrder {
    int nM, nN, nwg, G, c;
    __host__ __device__ void init(int M, int N, int G_, int c_) { nM = M / BM; nN = N / BM; nwg = nM * nN; G = G_; c = c_; }
    __host__ __device__ bool next(int i, Unit& u) const {
        const long L = (long)i * G + c; if (L >= nwg) return false;
        int wgid = (int)L; { const int q = nwg / NXCD, r = nwg % NXCD, xcd = wgid % NXCD, off = wgid / NXCD; wgid = (xcd < r ? xcd * (q + 1) : r * (q + 1) + (xcd - r) * q) + off; }
        const int nig = WGM * nN, gid = wgid / nig, fm = gid * WGM, gsz = (nM - fm) < WGM ? (nM - fm) : WGM;
        u.pm = fm + ((wgid % nig) % gsz); u.pn = (wgid % nig) / gsz; return true;
    }
};

template <class Epi, class Sched, bool ALIGN_EPI = false, bool SP2 = false>
__device__ __forceinline__ void gemm_phase(PG8_LAS unsigned char* lds, const Gemm g, const Sched& S, const Epi& E) {
    const int tid = tid_fresh(), wid = __builtin_amdgcn_readfirstlane(tid >> 6), lane = tid & 63, wr = wid >> 2, wc = wid & 3, fr = lane & 15, fq = lane >> 4;
    const int K = g.K, nt = K / BK;
    unsigned voffA[2], voffB[2];
#pragma unroll
    for (int i = 0; i < 2; ++i) { int R, C; stage_rc(tid * 16 + i * 8192, R, C); const int Rb = Epi::PERM ? ((R & ~31) + perm32(R & 31)) : R;
        voffA[i] = (unsigned)(R * g.lda + C) * 2u; voffB[i] = (unsigned)(Rb * g.ldb + C) * 2u; }
    const size_t kstep = (size_t)(BK * 2);
    const size_t hstepA = (size_t)HALF * g.lda * 2, hstepB = (size_t)HALF * g.ldb * 2;
    const size_t tstepA = 2 * hstepA, tstepB = 2 * hstepB;
    const unsigned ldsw = (unsigned)wid * 1024u;
    const int aoff = lds_byte(wr * 64 + fr, fq * 8), boff = lds_byte(wc * 32 + fr, fq * 8);
#define PG8_SA(b, h) (((b) * 2 + (h)) * HTB)
#define PG8_SB(b, h) ((4 + (b) * 2 + (h)) * HTB)
#define PG8_STAGE(bufoff, gbase, voff) do { _Pragma("unroll") for (int _i = 0; _i < 2; ++_i) \
        __builtin_amdgcn_global_load_lds((const unsigned*)((const char*)(gbase) + (voff)[_i]), (PG8_LAS unsigned*)(lds + (bufoff) + ldsw + _i * 8192), 16, 0, 0); } while (0)
#define PG8_LDA(dst, b, h) do { _Pragma("unroll") for (int m = 0; m < 4; ++m) _Pragma("unroll") for (int k = 0; k < 2; ++k) dst[m][k] = *(const PG8_LAS bf16x8*)(lds + PG8_SA(b, h) + aoff + m * 2048 + k * 1024); } while (0)
#define PG8_LDB(dst, b, h) do { _Pragma("unroll") for (int n = 0; n < 2; ++n) _Pragma("unroll") for (int k = 0; k < 2; ++k) dst[n][k] = *(const PG8_LAS bf16x8*)(lds + PG8_SB(b, h) + boff + n * 2048 + k * 1024); } while (0)
#define PG8_MMA(ai, bj, At, Bt) do { __builtin_amdgcn_s_setprio(1); _Pragma("unroll") for (int m = 0; m < 4; ++m) _Pragma("unroll") for (int n = 0; n < 2; ++n) _Pragma("unroll") for (int k = 0; k < 2; ++k) \
        acc[ai][bj][m][n] = __builtin_amdgcn_mfma_f32_16x16x32_bf16(Bt[n][k], At[m][k], acc[ai][bj][m][n], 0, 0, 0); __builtin_amdgcn_s_setprio(0); } while (0)
#define PG8_WAIT_V(n) asm volatile("s_waitcnt vmcnt(" #n ")" ::: "memory")
#define PG8_WAIT_L(n) asm volatile("s_waitcnt lgkmcnt(" #n ")" ::: "memory")
#define PG8_BAR __builtin_amdgcn_s_barrier()
#define PG8_SCHED __builtin_amdgcn_sched_barrier(0)
    Unit cur, nxt; int ui = 0;
    if (!S.next(0, cur)) return;
    f32x4 acc[2][2][4][2];
#pragma unroll
    for (int a = 0; a < 2; ++a)
#pragma unroll
        for (int b = 0; b < 2; ++b)
#pragma unroll
            for (int m = 0; m < 4; ++m)
#pragma unroll
                for (int n = 0; n < 2; ++n) acc[a][b][m][n] = (f32x4){0.f, 0.f, 0.f, 0.f};
    bf16x8 At[4][2], B0[2][2], B1[2][2];
    const char* cA = (const char*)g.A + (size_t)cur.pm * tstepA; const char* cB = (const char*)g.Bt + (size_t)cur.pn * tstepB;
    if constexpr (SP2) {
        PG8_STAGE(PG8_SB(0, 0), cB, voffB); PG8_STAGE(PG8_SB(0, 1), cB + hstepB, voffB); PG8_STAGE(PG8_SA(0, 0), cA, voffA); PG8_STAGE(PG8_SA(0, 1), cA + hstepA, voffA);
        if (wr == 1) PG8_BAR;
        PG8_WAIT_V(2); PG8_BAR;
        PG8_STAGE(PG8_SB(1, 0), cB + kstep, voffB); PG8_STAGE(PG8_SA(1, 0), cA + kstep, voffA); PG8_STAGE(PG8_SB(1, 1), cB + hstepB + kstep, voffB);
        PG8_WAIT_V(6); PG8_BAR;
    } else {
        PG8_STAGE(PG8_SB(0, 0), cB, voffB); PG8_STAGE(PG8_SA(0, 0), cA, voffA); PG8_STAGE(PG8_SB(0, 1), cB + hstepB, voffB); PG8_STAGE(PG8_SA(0, 1), cA + hstepA, voffA);
        if (wr == 1) PG8_BAR;
        PG8_WAIT_V(4); PG8_BAR;
        PG8_STAGE(PG8_SB(1, 0), cB + kstep, voffB); PG8_STAGE(PG8_SA(1, 0), cA + kstep, voffA); PG8_STAGE(PG8_SB(1, 1), cB + hstepB + kstep, voffB);
        PG8_WAIT_V(6); PG8_BAR;
    }
    for (;;) {
        const bool has_next = S.next(ui + 1, nxt);
        const char* nA = has_next ? (const char*)g.A + (size_t)nxt.pm * tstepA : cA; const char* nB = has_next ? (const char*)g.Bt + (size_t)nxt.pn * tstepB : cB;
        for (int t = 0; t < nt; t += 2) {
            if constexpr (Epi::MID) { if (t == (nt >> 1)) E.mid(acc, cur); }
            const bool last = (t == nt - 2);
            const char* a1 = cA + (size_t)(t + 1) * kstep;
            const char* a2 = last ? nA : cA + (size_t)(t + 2) * kstep; const char* b2 = last ? nB : cB + (size_t)(t + 2) * kstep;
            const char* a3 = a2 + kstep; const char* b3 = b2 + kstep;
            if constexpr (SP2) {
            PG8_LDB(B0, 0, 0); PG8_LDB(B1, 0, 1); PG8_SCHED; PG8_LDA(At, 0, 0); PG8_STAGE(PG8_SA(1, 1), a1 + hstepA, voffA);
            PG8_WAIT_V(8); PG8_WAIT_L(0); PG8_BAR; PG8_MMA(0, 0, At, B0); PG8_MMA(0, 1, At, B1); PG8_BAR; PG8_SCHED;
            PG8_LDA(At, 0, 1); PG8_STAGE(PG8_SB(0, 0), b2, voffB); PG8_STAGE(PG8_SB(0, 1), b2 + hstepB, voffB); PG8_STAGE(PG8_SA(0, 0), a2, voffA);
            PG8_WAIT_V(8); PG8_WAIT_L(0); PG8_BAR; PG8_MMA(1, 0, At, B0); PG8_MMA(1, 1, At, B1); PG8_BAR; PG8_SCHED;
            PG8_LDB(B0, 1, 0); PG8_LDB(B1, 1, 1); PG8_SCHED; PG8_LDA(At, 1, 0); PG8_STAGE(PG8_SA(0, 1), a2 + hstepA, voffA);
            PG8_WAIT_V(8); PG8_WAIT_L(0); PG8_BAR; PG8_MMA(0, 0, At, B0); PG8_MMA(0, 1, At, B1); PG8_BAR; PG8_SCHED;
            PG8_LDA(At, 1, 1); PG8_STAGE(PG8_SB(1, 0), b3, voffB); PG8_STAGE(PG8_SB(1, 1), b3 + hstepB, voffB); PG8_STAGE(PG8_SA(1, 0), a3, voffA);
            PG8_WAIT_V(8); PG8_WAIT_L(0); PG8_BAR; PG8_MMA(1, 0, At, B0); PG8_MMA(1, 1, At, B1); PG8_BAR; PG8_SCHED;
            } else {
            PG8_LDB(B0, 0, 0); PG8_SCHED; PG8_LDA(At, 0, 0); PG8_STAGE(PG8_SA(1, 1), a1 + hstepA, voffA);
            PG8_WAIT_L(8); PG8_BAR; PG8_WAIT_L(0); PG8_MMA(0, 0, At, B0); PG8_BAR; PG8_SCHED;
            PG8_LDB(B1, 0, 1); PG8_STAGE(PG8_SB(0, 0), b2, voffB);
            PG8_BAR; PG8_WAIT_L(0); PG8_MMA(0, 1, At, B1); PG8_BAR;
            PG8_LDA(At, 0, 1); PG8_STAGE(PG8_SA(0, 0), a2, voffA);
            PG8_BAR; PG8_WAIT_L(0); PG8_MMA(1, 0, At, B0); PG8_BAR; PG8_SCHED;
            PG8_STAGE(PG8_SB(0, 1), b2 + hstepB, voffB);
            PG8_WAIT_V(6); PG8_BAR; PG8_MMA(1, 1, At, B1); PG8_BAR;
            PG8_LDB(B0, 1, 0); PG8_SCHED; PG8_LDA(At, 1, 0); PG8_STAGE(PG8_SA(0, 1), a2 + hstepA, voffA);
            PG8_WAIT_L(8); PG8_BAR; PG8_WAIT_L(0); PG8_MMA(0, 0, At, B0); PG8_BAR; PG8_SCHED;
            PG8_LDB(B1, 1, 1); PG8_STAGE(PG8_SB(1, 0), b3, voffB);
            PG8_BAR; PG8_WAIT_L(0); PG8_MMA(0, 1, At, B1); PG8_BAR;
            PG8_LDA(At, 1, 1); PG8_STAGE(PG8_SA(1, 0), a3, voffA);
            PG8_BAR; PG8_WAIT_L(0); PG8_MMA(1, 0, At, B0); PG8_BAR; PG8_SCHED;
            PG8_STAGE(PG8_SB(1, 1), b3 + hstepB, voffB);
            PG8_WAIT_V(6); PG8_BAR; PG8_MMA(1, 1, At, B1); PG8_BAR;
            }
        }
        if constexpr (ALIGN_EPI) { if (wr == 0) PG8_BAR; }
        E(acc, cur, wr, wc, fr, fq);
        if (!has_next) break;
#pragma unroll
        for (int a = 0; a < 2; ++a)
#pragma unroll
            for (int b = 0; b < 2; ++b)
#pragma unroll
                for (int m = 0; m < 4; ++m)
#pragma unroll
                    for (int n = 0; n < 2; ++n) acc[a][b][m][n] = (f32x4){0.f, 0.f, 0.f, 0.f};
        cur = nxt; cA = nA; cB = nB; ++ui;
        if constexpr (ALIGN_EPI) { if (wr == 1) PG8_BAR; }
    }
    PG8_WAIT_V(0);
    if constexpr (!ALIGN_EPI) { if (wr == 0) PG8_BAR; }
    PG8_BAR;
#undef PG8_SA
#undef PG8_SB
#undef PG8_STAGE
#undef PG8_LDA
#undef PG8_LDB
#undef PG8_MMA
#undef PG8_WAIT_V
#undef PG8_WAIT_L
#undef PG8_BAR
#undef PG8_SCHED
}
}

template <class F> struct EpiAd {
    static constexpr bool PERM = true, AFTER_DRAIN = false, MID = false;
    F f;
    __device__ __forceinline__ void operator()(const pg8::f32x4 (&acc)[2][2][4][2], const pg8::Unit& u, int wr, int wc, int fr, int fq) const {
        const int row0 = u.pm * 256 + wr * 64 + fr, col0 = u.pn * 256 + wc * 32 + 8 * fq;
#pragma unroll
        for (int ai = 0; ai < 2; ++ai)
#pragma unroll
            for (int m = 0; m < 4; ++m)
            {
                float q = 0.f;
#pragma unroll
                for (int bj = 0; bj < 2; ++bj) {
                    float v[8];
#pragma unroll
                    for (int e = 0; e < 4; ++e) { v[e] = acc[ai][bj][m][0][e]; v[4 + e] = acc[ai][bj][m][1][e]; }
                    q += f.apply(row0 + ai * 128 + m * 16, col0 + bj * 128, v);
                }
                if constexpr (F::ROWSUM) {
                    q += __shfl_xor(q, 16); q += __shfl_xor(q, 32);
                    if (fq == 0) __hip_atomic_fetch_add(f.ss + row0 + ai * 128 + m * 16, q, __ATOMIC_RELAXED, __HIP_MEMORY_SCOPE_AGENT);
                }
            }
    }
};

struct EpiMerge {
    static constexpr bool PERM = true, AFTER_DRAIN = false, MID = true;
    const bf16* proj; bf16* merged;
    __device__ __forceinline__ void mid(pg8::f32x4 (&acc)[2][2][4][2], const pg8::Unit& u) const {
        const int tid = tid_fresh(), wid = __builtin_amdgcn_readfirstlane(tid >> 6), lane = tid & 63, wr = wid >> 2, wc = wid & 3, fr = lane & 15, fq = lane >> 4;
        const int row0 = u.pm * 256 + wr * 64 + fr, col0 = u.pn * 256 + wc * 32 + 8 * fq;
#pragma unroll
        for (int ai = 0; ai < 2; ++ai) {
            u32x4 ga[4][2], gb[4][2];
#pragma unroll
            for (int m = 0; m < 4; ++m)
#pragma unroll
                for (int bj = 0; bj < 2; ++bj) {
                    const bf16* gp = proj + (size_t)(row0 + ai * 128 + m * 16) * N1 + C_GATE + col0 + bj * 128;
                    ga[m][bj] = *(const u32x4*)gp; gb[m][bj] = *(const u32x4*)(gp + DM);
                }
#pragma unroll
            for (int m = 0; m < 4; ++m)
#pragma unroll
                for (int bj = 0; bj < 2; ++bj) {
                    float a[8], b[8]; unpack8(ga[m][bj], a); unpack8(gb[m][bj], b);
#pragma unroll
                    for (int e = 0; e < 4; ++e) {
                        acc[ai][bj][m][0][e] *= b[e] * __builtin_amdgcn_rcpf(fmaxf(a[e], 1e-30f));
                        acc[ai][bj][m][1][e] *= b[4 + e] * __builtin_amdgcn_rcpf(fmaxf(a[4 + e], 1e-30f));
                    }
                }
            __builtin_amdgcn_sched_barrier(0);
        }
    }
    __device__ __forceinline__ void operator()(const pg8::f32x4 (&acc)[2][2][4][2], const pg8::Unit& u, int, int, int, int) const {
        const int tid = tid_fresh(), wid = __builtin_amdgcn_readfirstlane(tid >> 6), lane = tid & 63, wr = wid >> 2, wc = wid & 3, fr = lane & 15, fq = lane >> 4;
        const int row0 = u.pm * 256 + wr * 64 + fr, col0 = u.pn * 256 + wc * 32 + 8 * fq;
#pragma unroll
        for (int ai = 0; ai < 2; ++ai)
#pragma unroll
            for (int m = 0; m < 4; ++m)
#pragma unroll
                for (int bj = 0; bj < 2; ++bj) {
                    const int row = row0 + ai * 128 + m * 16, col = col0 + bj * 128;
                    float ga[8], v[8]; unpack8(*(const u32x4*)(proj + (size_t)row * N1 + C_GATE + col), ga);
#pragma unroll
                    for (int e = 0; e < 4; ++e) { v[e] = acc[ai][bj][m][0][e] * ga[e]; v[4 + e] = acc[ai][bj][m][1][e] * ga[4 + e]; }
                    *(u32x4*)(merged + (size_t)row * DM + col) = pack8(v);
                }
    }
};

template <class F, bool ALIGN = true>
__device__ __forceinline__ void big_gemm(LAS unsigned char* lds, const bf16* A, int lda, const bf16* Bt, int ldb, int N, int K, const F& f) {
    pg8::Gemm g{A, Bt, MP, N, K, lda, ldb}; pg8::StaticOrder S; S.init(MP, N, (int)gridDim.x, (int)blockIdx.x);
    EpiAd<F> E{f};
    pg8::gemm_phase<EpiAd<F>, pg8::StaticOrder, ALIGN, true>(lds, g, S, E);
}

template <class F>
__device__ __forceinline__ void small_gemm(LAS unsigned char* lds, const bf16* A  , int lda, const bf16* Bt, int ldb, int N, int K, const F& f) {
    const int tid = tid_fresh(), wave = tid >> 6, lane = tid & 63, fr = lane & 15, fq = lane >> 4;
    LAS float* red = (LAS float*)lds;
    const int ntask = N / 16, kw = K / 8;
    for (int task = (int)(gridDim.x - 1 - blockIdx.x); task < ntask; task += gridDim.x) {
        const int n0 = task * 16;
        f32x4 c0 = {0.f, 0.f, 0.f, 0.f}, c1 = {0.f, 0.f, 0.f, 0.f};
        const bf16* a0 = A + (size_t)fr * lda + wave * kw + fq * 8;
        const bf16* a1 = a0 + (size_t)16 * lda;
        const bf16* bp = Bt + (size_t)(n0 + fr) * ldb + wave * kw + fq * 8;
#pragma unroll 8
        for (int k = 0; k < kw; k += 32) {
            const bf16x8 av0 = *(const bf16x8*)(a0 + k), av1 = *(const bf16x8*)(a1 + k), bv = *(const bf16x8*)(bp + k);
            c0 = __builtin_amdgcn_mfma_f32_16x16x32_bf16(av0, bv, c0, 0, 0, 0);
            c1 = __builtin_amdgcn_mfma_f32_16x16x32_bf16(av1, bv, c1, 0, 0, 0);
        }
#pragma unroll
        for (int r = 0; r < 4; ++r) { red[(wave * 32 + fq * 4 + r) * 16 + fr] = c0[r]; red[(wave * 32 + 16 + fq * 4 + r) * 16 + fr] = c1[r]; }
        __syncthreads();
        if (tid < 64) {
            const int row = tid >> 1, c8 = (tid & 1) * 8;
            float v[8];
#pragma unroll
            for (int e = 0; e < 8; ++e) v[e] = 0.f;
#pragma unroll
            for (int w = 0; w < 8; ++w)
#pragma unroll
                for (int e = 0; e < 8; ++e) v[e] += red[(w * 32 + row) * 16 + c8 + e];
            const float q = f.apply(MP + row, n0 + c8, v);
            if constexpr (F::ROWSUM) __hip_atomic_fetch_add(f.ss + MP + row, q, __ATOMIC_RELAXED, __HIP_MEMORY_SCOPE_AGENT);
        }
        __syncthreads();
    }
}

template <class F>
__device__ __forceinline__ void small_gemm_dual(LAS unsigned char* lds, const bf16* A, int lda, const bf16* Bt, int ldb, int N, const F& f) {
    const int tid = tid_fresh(), wave = tid >> 6, lane = tid & 63, fr = lane & 15, fq = lane >> 4;
    LAS float* red = (LAS float*)lds;
    const int ntask = N / 16, kw = 256;
    for (int task = (int)(gridDim.x - 1 - blockIdx.x); task < ntask; task += gridDim.x) {
        const int n0 = task * 16;
        f32x4 c0 = {0.f, 0.f, 0.f, 0.f}, c1 = {0.f, 0.f, 0.f, 0.f};
        const bf16* a0 = A + (size_t)fr * lda + wave * kw + fq * 8;
        const bf16* a1 = a0 + (size_t)16 * lda;
        const bf16* bp = Bt + (size_t)(n0 + fr) * ldb + wave * kw + fq * 8;
#pragma unroll
        for (int k = 0; k < kw; k += 32) {
            const bf16x8 av0 = *(const bf16x8*)(a0 + k), av1 = *(const bf16x8*)(a1 + k), bv = *(const bf16x8*)(bp + k);
            c0 = __builtin_amdgcn_mfma_f32_16x16x32_bf16(av0, bv, c0, 0, 0, 0);
            c1 = __builtin_amdgcn_mfma_f32_16x16x32_bf16(av1, bv, c1, 0, 0, 0);
        }
#pragma unroll
        for (int r = 0; r < 4; ++r) { red[(wave * 32 + fq * 4 + r) * 16 + fr] = c0[r]; red[(wave * 32 + 16 + fq * 4 + r) * 16 + fr] = c1[r]; }
        __syncthreads();
        if (tid < 64) {
            const int row = tid >> 1, c8 = (tid & 1) * 8;
            float va[8], vb[8];
#pragma unroll
            for (int e = 0; e < 8; ++e) { va[e] = 0.f; vb[e] = 0.f; }
#pragma unroll
            for (int w = 0; w < 4; ++w)
#pragma unroll
                for (int e = 0; e < 8; ++e) { va[e] += red[(w * 32 + row) * 16 + c8 + e]; vb[e] += red[((w + 4) * 32 + row) * 16 + c8 + e]; }
            f.apply2(MP + row, n0 + c8, va, vb);
        }
        __syncthreads();
    }
}

__device__ __forceinline__ void st8f(float* o, const float (&v)[8]) { *(f32x4*)o = (f32x4){v[0], v[1], v[2], v[3]}; *(f32x4*)(o + 4) = (f32x4){v[4], v[5], v[6], v[7]}; }
__device__ __forceinline__ void ld8f(const float* o, float (&v)[8]) { const f32x4 a = *(const f32x4*)o, b = *(const f32x4*)(o + 4); v[0] = a.x; v[1] = a.y; v[2] = a.z; v[3] = a.w; v[4] = b.x; v[5] = b.y; v[6] = b.z; v[7] = b.w; }

struct E1 {
    static constexpr bool ROWSUM = false;
    bf16* proj; const float* b_gate; float* out;
    __device__ __forceinline__ float apply(int row, int col, float (&v)[8]) const {
        if (col >= C_GATE) {
            float b[8]; ld8f(b_gate + (col - C_GATE), b);
#pragma unroll
            for (int e = 0; e < 8; ++e) v[e] = sigmoidf_(v[e] + b[e]);
        } else if (col >= C_GU) {
#pragma unroll
            for (int e = 0; e < 8; ++e) v[e] = gelu_tanh(v[e]);
        } else if (col >= C_V) {
            if (row < MP) { const int t = row & (SEQ - 1); if (t >= SEQ - 128) st8f(out + OFF_VP + ((size_t)((row >> 11) * 128 + (t - (SEQ - 128)))) * 256 + (col - C_V), v); }
            else st8f(out + OFF_VS + ((size_t)((row - MP) * 128 + 127)) * 256 + (col - C_V), v);
        }
        *(u32x4*)(proj + (size_t)row * N1 + col) = pack8(v);
        return 0.f;
    }
};
struct E2s {
    const bf16* proj; bf16* merged;
    __device__ __forceinline__ void apply2(int row, int col, float (&va)[8], float (&vb)[8]) const {
        float ga[8], gb[8]; unpack8(*(const u32x4*)(proj + (size_t)row * N1 + C_GATE + col), ga); unpack8(*(const u32x4*)(proj + (size_t)row * N1 + C_GATE + DM + col), gb);
#pragma unroll
        for (int e = 0; e < 8; ++e) va[e] = gb[e] * va[e] + ga[e] * vb[e];
        *(u32x4*)(merged + (size_t)row * DM + col) = pack8(va);
    }
};
struct E3 {
    static constexpr bool ROWSUM = true;
    const float *xp, *xs; bf16* res; const float* nw; bf16* xn; float* ss;
    __device__ __forceinline__ float apply(int row, int col, float (&v)[8]) const {
        const float* xr = row < MP ? xp + (size_t)row * DM : xs + (size_t)(row - MP) * DM;
        float x[8], w[8]; ld8f(xr + col, x); ld8f(nw + col, w);
        float q = 0.f;
#pragma unroll
        for (int e = 0; e < 8; ++e) { v[e] += x[e]; q += v[e] * v[e]; }
        *(u32x4*)(res + (size_t)row * DM + col) = pack8(v);
#pragma unroll
        for (int e = 0; e < 8; ++e) v[e] *= w[e];
        *(u32x4*)(xn + (size_t)row * DM + col) = pack8(v);
        return q;
    }
};
struct E4s {
    static constexpr bool ROWSUM = false;
    float* hs; float* out; const float* ss;
    __device__ __forceinline__ float apply(int row, int col, float (&v)[8]) const {
        const float rs = rsqrtf(ss[row] * (1.f / DM) + EPS);
#pragma unroll
        for (int e = 0; e < 8; ++e) v[e] *= rs;
        const int ch = (col >> 8) * 128 + (col & 127) + ((col & 128) ? DFF : 0);
        st8f(out + OFF_CS + ((size_t)((row - MP) * 2 + 1)) * NUP + ch, v);
        st8f(hs + (size_t)(row - MP) * NUP + col, v);
        return 0.f;
    }
};
template <int CTRL> __device__ __forceinline__ unsigned dppu(unsigned old, unsigned src) { return (unsigned)__builtin_amdgcn_update_dpp((int)old, (int)src, CTRL, 0xf, 0xf, false); }
template <int CTRL> __device__ __forceinline__ float dppf(float old, float src) {
    return __builtin_bit_cast(float, __builtin_amdgcn_update_dpp(__builtin_bit_cast(int, old), __builtin_bit_cast(int, src), CTRL, 0xf, 0xf, false));
}
struct EpiConv {
    static constexpr bool PERM = true, AFTER_DRAIN = false, MID = false;
    bf16* act; float* out; const float* ss; const float* cw; const float* cb; float* hb; LAS float* xb;
    __device__ __forceinline__ void operator()(const pg8::f32x4 (&acc)[2][2][4][2], const pg8::Unit& u, int, int, int, int) const {
        const int tid = tid_fresh(), wid = __builtin_amdgcn_readfirstlane(tid >> 6), lane = tid & 63, wr = wid >> 2, wc = wid & 3, fr = lane & 15, fq = lane >> 4;
        const int rowb = u.pm * 256 + wr * 64 + fr, cl = wc * 32 + 8 * fq, chg = u.pn * 128 + cl;
#define RS_(ai_, m_) __builtin_amdgcn_rsqf(ssl[(unsigned)(rowb + (ai_) * 128 + (m_) * 16)] * (1.f / DM) + EPS)
        const float* ssl = ss; asm volatile("" : "+s"(ssl));
        if (fr >= 14) {
#pragma unroll
            for (int ai = 0; ai < 2; ++ai) { LAS float* d = xb + ((ai * 2 + wr) * 2 + (fr - 14)) * 256 + cl; const float r3 = RS_(ai, 3);
#pragma unroll
                for (int bj = 0; bj < 2; ++bj) { *(LAS f32x4*)(d + bj * 128) = acc[ai][bj][3][0] * r3; *(LAS f32x4*)(d + bj * 128 + 4) = acc[ai][bj][3][1] * r3; } }
        }
        if (wr == 0 && fr < 2) { float* d = hb + (unsigned)((u.pm * 4 + fr) * NUP + u.pn * 256 + cl); const float r0 = RS_(0, 0);
#pragma unroll
            for (int bj = 0; bj < 2; ++bj) { *(f32x4*)(d + bj * 128) = acc[0][bj][0][0] * r0; *(f32x4*)(d + bj * 128 + 4) = acc[0][bj][0][1] * r0; } }
        if (wr == 1 && fr >= 14) { float* d = hb + (unsigned)((u.pm * 4 + 2 + fr - 14) * NUP + u.pn * 256 + cl); const float r3 = RS_(1, 3);
#pragma unroll
            for (int bj = 0; bj < 2; ++bj) { *(f32x4*)(d + bj * 128) = acc[1][bj][3][0] * r3; *(f32x4*)(d + bj * 128 + 4) = acc[1][bj][3][1] * r3; } }
        {
            LAS float* wl = xb + (WL_OFF - 131072) / 4; LAS float* rsl = xb + (RSL_OFF - 131072) / 4;
            const int idx = tid * 2, k = idx >> 8, c = idx & 255;
            const int chn = (c < 128) ? u.pn * 128 + c : DFF + u.pn * 128 + (c - 128);
            const float* src = (k < 3) ? cw + (unsigned)(k * NUP + chn) : cb + (unsigned)chn;
            const f32x2_t wv = *(const f32x2_t*)src;
            *(LAS f32x2_t*)(wl + idx) = wv;
            if (tid < 256) rsl[tid] = __builtin_amdgcn_rsqf(ssl[(unsigned)(u.pm * 256 + tid)] * (1.f / DM) + EPS);
        }
        __builtin_amdgcn_sched_barrier(0);
        asm volatile("s_waitcnt lgkmcnt(0)" ::: "memory");
        __builtin_amdgcn_s_barrier();
        const LAS float* wl = xb + (WL_OFF - 131072) / 4; const LAS float* rsl = xb + (RSL_OFF - 131072) / 4 + wr * 64 + fr;
#pragma unroll
        for (int ai = 0; ai < 2; ++ai)
#pragma unroll
            for (int m = 0; m < 4; ++m) {
                const int row = rowb + ai * 128 + m * 16, t = row & (SEQ - 1);
                const float rsc = rsl[ai * 128 + m * 16], rsp = rsl[ai * 128 + (m > 0 ? m - 1 : 0) * 16];
                unsigned opk[4];
#pragma unroll
                for (int n = 0; n < 2; ++n) {
                    float o[4];
#pragma unroll
                    for (int bj = 0; bj < 2; ++bj) {
                        const int ch = chg + bj * DFF;
                        const f32x4 cur = acc[ai][bj][m][n] * rsc;
                        f32x4 xp = {0.f, 0.f, 0.f, 0.f};
                        if (m > 0) xp = acc[ai][bj][m > 0 ? m - 1 : 0][n] * rsp;
                        else if (!(ai == 0 && wr == 0) && fr >= 14)
                            xp = *(const LAS f32x4*)(xb + ((wr == 1 ? (ai * 2 + 0) : ((ai - 1) * 2 + 1)) * 2 + (fr - 14)) * 256 + bj * 128 + cl + 4 * n);
                        const unsigned c01 = pk2m(cur[0], cur[1]), c23 = pk2m(cur[2], cur[3]), x01 = pk2m(xp[0], xp[1]), x23 = pk2m(xp[2], xp[3]);
                        unsigned a01 = dppu<0x111>(dppu<0x121>(0u, x01), c01), a23 = dppu<0x111>(dppu<0x121>(0u, x23), c23);
                        unsigned b01 = dppu<0x112>(dppu<0x122>(0u, x01), c01), b23 = dppu<0x112>(dppu<0x122>(0u, x23), c23);
                        if (t < 1) { a01 = 0u; a23 = 0u; }
                        if (t < 2) { b01 = 0u; b23 = 0u; }
                        const float p1[4] = {bf_lo(a01), bf_hi(a01), bf_lo(a23), bf_hi(a23)}, p2[4] = {bf_lo(b01), bf_hi(b01), bf_lo(b23), bf_hi(b23)};
                        const LAS float* wp = wl + bj * 128 + cl + 4 * n;
                        const f32x4 w0 = *(const LAS f32x4*)wp, w1 = *(const LAS f32x4*)(wp + 256), w2 = *(const LAS f32x4*)(wp + 512), bb = *(const LAS f32x4*)(wp + 768);
                        if (t >= SEQ - 2) *(f32x4*)(out + OFF_CP + (unsigned)(((row >> 11) * 2 + (t - (SEQ - 2))) * NUP + ch + 4 * n)) = cur;
#pragma unroll
                        for (int e = 0; e < 4; ++e) {
                            const float hc = w0[e] * p2[e] + w1[e] * p1[e] + w2[e] * cur[e] + bb[e];
                            if (bj == 0) o[e] = silu_(hc); else o[e] *= hc;
                        }
                    }
                    opk[2 * n] = pk2(o[0], o[1]); opk[2 * n + 1] = pk2(o[2], o[3]);
                }
                *(u32x4*)(act + (unsigned)(row * DFF + chg)) = (u32x4){opk[0], opk[1], opk[2], opk[3]};
                __builtin_amdgcn_sched_barrier(0);
            }
#undef RS_
    }
};
struct E5 {
    static constexpr bool ROWSUM = true;
    const bf16* rin; bf16* rout; const float* nw; bf16* xn; float* ss;
    __device__ __forceinline__ float apply(int row, int col, float (&v)[8]) const {
        float x[8], w[8]; unpack8(*(const u32x4*)(rin + (size_t)row * DM + col), x); ld8f(nw + col, w);
        float q = 0.f;
#pragma unroll
        for (int e = 0; e < 8; ++e) { v[e] += x[e]; q += v[e] * v[e]; }
        *(u32x4*)(rout + (size_t)row * DM + col) = pack8(v);
#pragma unroll
        for (int e = 0; e < 8; ++e) v[e] *= w[e];
        *(u32x4*)(xn + (size_t)row * DM + col) = pack8(v);
        return q;
    }
};
struct E6a {
    static constexpr bool ROWSUM = false;
    bf16* pp;
    __device__ __forceinline__ float apply(int row, int col, float (&v)[8]) const { *(u32x4*)(pp + (size_t)row * DM + col) = pack8(v); return 0.f; }
};
struct E6b {
    static constexpr bool ROWSUM = false;
    const bf16* pp; const bf16* res; float* y; const float* ss;
    __device__ __forceinline__ float apply(int row, int col, float (&v)[8]) const {
        const float rs = rsqrtf(ss[row] * (1.f / DM) + EPS);
        float x[8], q[8]; unpack8(*(const u32x4*)(res + (size_t)row * DM + col), x); unpack8(*(const u32x4*)(pp + (size_t)row * DM + col), q);
#pragma unroll
        for (int e = 0; e < 8; ++e) v[e] = x[e] + sigmoidf_(v[e] * rs) * q[e];
        st8f(y + (size_t)row * DM + col, v);
        return 0.f;
    }
};

struct TItem { const float* src; bf16* dst; int N, ldk; };
constexpr int I_IN = 32 * 112, I_GATE = 32 * 128, I_BA = 16 * 64, I_BG = 16 * 64, I_OUT = 32 * 64, I_UP = 32 * 352, I_DOWN = 88 * 64, I_PG = 32 * 64, I_PP = 4 * 64;
constexpr int NITEMS = I_IN + I_GATE + I_BA + I_BG + I_OUT + I_UP + I_DOWN + I_PG + I_PP, I_EARLY = I_IN + I_GATE + I_PP, I_MID = I_EARLY + I_BA + I_BG + I_OUT;
__device__ __forceinline__ TItem titem_mk(const float* W, int N, bf16* WT, int ldk, int item, bool upperm) {
    const int nblk = N / 32, kb = item / nblk, nb = item - kb * nblk, k0 = 64 * kb, n0 = 32 * nb;
    const int r0 = !upperm ? n0 : (n0 < DFF ? (n0 >> 7) * 256 + (n0 & 127) : ((n0 - DFF) >> 7) * 256 + 128 + ((n0 - DFF) & 127));
    TItem t; t.src = W + (size_t)k0 * N + n0; t.dst = WT + (size_t)r0 * ldk + k0; t.N = N; t.ldk = ldk; return t;
}
__device__ __forceinline__ TItem titem(KP p, int it) {
    unsigned char* ws = p->ws; int r = it;
    if (r < I_IN) return titem_mk(p->w_in, 3584, (bf16*)(ws + WS_W1), 2048, r, false); r -= I_IN;
    if (r < I_GATE) return titem_mk(p->w_gate, 4096, (bf16*)(ws + WS_W1) + (size_t)C_GATE * 2048, 2048, r, false); r -= I_GATE;
    if (r < I_PP) return titem_mk(p->w_ple_proj, 2048, (bf16*)(ws + WS_WPP), PLE, r, false); r -= I_PP;
    if (r < I_BA) return titem_mk(p->w_br_attn, 2048, (bf16*)(ws + WS_WBA), 2048, r, false); r -= I_BA;
    if (r < I_BG) return titem_mk(p->w_br_gm, 2048, (bf16*)(ws + WS_WBA) + 1024, 2048, r, false); r -= I_BG;
    if (r < I_OUT) return titem_mk(p->w_out, 2048, (bf16*)(ws + WS_WOUT), 2048, r, false); r -= I_OUT;
    if (r < I_UP) return titem_mk(p->w_up, NUP, (bf16*)(ws + WS_WUP), 2048, r, true); r -= I_UP;
    if (r < I_DOWN) return titem_mk(p->w_down, 2048, (bf16*)(ws + WS_WDOWN), DFF, r, false); r -= I_DOWN;
    return titem_mk(p->w_ple_gate, 2048, (bf16*)(ws + WS_WPG), 2048, r, false);
}
__device__ __forceinline__ void tload(const TItem& s, f32x4 (&t)[8], int lane) {
#pragma unroll
    for (int j = 0; j < 8; ++j) t[j] = __builtin_nontemporal_load((const f32x4*)(s.src + (size_t)((lane >> 3) + 8 * j) * s.N + (lane & 7) * 4));
}
__device__ __forceinline__ void tstore(const TItem& s, const f32x4 (&t)[8], LAS float* scr, int lane) {
#pragma unroll
    for (int j = 0; j < 8; ++j) { LAS float* d = scr + ((lane >> 3) + 8 * j) * 33 + (lane & 7) * 4; d[0] = t[j].x; d[1] = t[j].y; d[2] = t[j].z; d[3] = t[j].w; }
    asm volatile("s_waitcnt lgkmcnt(0)" ::: "memory");
    const int c = lane & 7;
#pragma unroll
    for (int j = 0; j < 4; ++j) { const int n = (lane >> 3) + 8 * j; const LAS float* q = scr + (8 * c) * 33 + n;
        u32x4 o; o.x = pk2(q[0 * 33], q[1 * 33]); o.y = pk2(q[2 * 33], q[3 * 33]); o.z = pk2(q[4 * 33], q[5 * 33]); o.w = pk2(q[6 * 33], q[7 * 33]);
        *(u32x4*)(s.dst + (size_t)n * s.ldk + 8 * c) = o; }
    asm volatile("s_waitcnt lgkmcnt(0)" ::: "memory");
}
__device__ __forceinline__ void convert_items(LAS unsigned char* lds, KP p, int lo, int hi, int w, int NW, int wave, int lane) {
    LAS float* scr = (LAS float*)(lds + wave * 16384);
    int it = lo + w; if (it >= hi) return;
    TItem cur = titem(p, it); f32x4 t[8]; tload(cur, t, lane);
    for (;;) {
        const int nx = it + NW; const bool has = nx < hi;
        TItem nxt = cur; f32x4 tn[8];
#pragma unroll
        for (int j = 0; j < 8; ++j) tn[j] = t[j];
        if (has) { nxt = titem(p, nx); tload(nxt, tn, lane); }
        tstore(cur, t, scr, lane);
        if (!has) break;
        cur = nxt; it = nx;
#pragma unroll
        for (int j = 0; j < 8; ++j) t[j] = tn[j];
    }
}
__device__ __forceinline__ void rms_row(const float* xrow, const float* w, bf16* orow, int lane) {
    f32x4 v[8]; float s = 0.f;
#pragma unroll
    for (int j = 0; j < 8; ++j) { v[j] = __builtin_nontemporal_load((const f32x4*)(xrow + lane * 4 + 256 * j)); s += (v[j].x * v[j].x + v[j].y * v[j].y) + (v[j].z * v[j].z + v[j].w * v[j].w); }
    const float rs = rsqrtf(wave_sum(s) * (1.f / DM) + EPS);
#pragma unroll
    for (int j = 0; j < 8; ++j) { const f32x4 ww = *(const f32x4*)(w + lane * 4 + 256 * j);
        u32x2 o; o.x = pk2(v[j].x * rs * ww.x, v[j].y * rs * ww.y); o.y = pk2(v[j].z * rs * ww.z, v[j].w * rs * ww.w);
        *(u32x2*)(orow + lane * 4 + 256 * j) = o; }
}
__device__ __forceinline__ void rms_phase(const float* src  , const float* w, bf16* dst) {
    const int tid = tid_fresh(), lane = tid & 63, gw = blockIdx.x * 8 + (tid >> 6), NGW = gridDim.x * 8;
    for (int m = gw; m < MALL; m += NGW) rms_row(src + (size_t)m * DM, w, dst + (size_t)m * DM, lane);
}

__device__ __forceinline__ void p0_phase(LAS unsigned char* lds, KP p) {
    const int tid = tid_fresh(), lane = tid & 63, wave = tid >> 6, gw = blockIdx.x * 8 + wave, NGW = gridDim.x * 8;
    unsigned char* ws = p->ws;
    convert_items(lds, p, 0, I_EARLY, blockIdx.x * 8 + __builtin_amdgcn_readfirstlane(wave), NGW, wave, lane);
    for (int i = blockIdx.x * 512 + tid; i < 32768; i += gridDim.x * 512) ((float*)ws)[i] = 0.f;
    bf16* XN = (bf16*)(ws + WS_XN); bf16* PBF = (bf16*)(ws + WS_PBF);
    for (int m = gw; m < MALL; m += NGW) {
        const float* xr = m < MP ? p->x_prompt + (size_t)m * DM : p->x_sample + (size_t)(m - MP) * DM;
        rms_row(xr, p->attn_norm_w, XN + (size_t)m * DM, lane);
        const float* pr = m < MP ? p->p_prompt + (size_t)m * PLE : p->p_sample + (size_t)(m - MP) * PLE;
        const f32x4 pv = *(const f32x4*)(pr + lane * 4);
        u32x2 o; o.x = pk2(pv.x, pv.y); o.y = pk2(pv.z, pv.w);
        *(u32x2*)(PBF + (size_t)m * PLE + lane * 4) = o;
    }
}

__device__ __forceinline__ void attn_prompt_unit(LAS unsigned char* lds, KP p, const bf16* proj, bf16* mix, int unit) {
    const int tid = tid_fresh(), wave = tid >> 6, lane = tid & 63, fr = lane & 15, fq = lane >> 4;
    const int kh = unit & 3, c = (unit >> 2) & 15, b = unit >> 6;
    LAS bf16* Ks = (LAS bf16*)lds;
    LAS bf16* Vt = (LAS bf16*)(lds + 36864);
#pragma unroll
    for (int i = 0; i < 4; ++i) {
        const int id = tid + 512 * i, j = id >> 3, ch = id & 7;
        const int pos = 128 * (c - 1) + j;
        u32x4 kraw = {0u, 0u, 0u, 0u}, vraw = {0u, 0u, 0u, 0u};
        if (pos >= 0) { const bf16* rp = proj + (size_t)(b * SEQ + pos) * N1; kraw = *(const u32x4*)(rp + C_K + kh * 64 + ch * 8); vraw = *(const u32x4*)(rp + C_V + kh * 64 + ch * 8); }
        float kf[8]; unpack8(kraw, kf);
        float ss = 0.f;
#pragma unroll
        for (int e = 0; e < 8; ++e) ss += kf[e] * kf[e];
        ss += __shfl_xor(ss, 1); ss += __shfl_xor(ss, 2); ss += __shfl_xor(ss, 4);
        const float rs = rsqrtf(ss * (1.f / 64.f) + EPS);
        float kw[8]; ld8f(p->k_norm_w + ch * 8, kw);
#pragma unroll
        for (int e = 0; e < 8; ++e) kf[e] = kf[e] * rs * kw[e];
        if (pos >= SEQ - 128) st8f(p->out + OFF_KP + ((size_t)((b * 128 + pos - (SEQ - 128)) * 4 + kh)) * 64 + ch * 8, kf);
        *(LAS u32x4*)(Ks + j * 72 + ch * 8) = pack8(kf);
        const unsigned vw[4] = {vraw.x, vraw.y, vraw.z, vraw.w};
#pragma unroll
        for (int e = 0; e < 8; ++e) Vt[(ch * 8 + e) * 264 + j] = (bf16)((e & 1) ? (vw[e >> 1] >> 16) : (vw[e >> 1] & 0xffffu));
    }
    __syncthreads();
    const int h = kh * 4 + (wave >> 1);
    const float slope = exp2f(-0.5f * (float)(h + 1)), sink = p->sinks[h];
    float qw0[8], qw1[8]; ld8f(p->q_norm_w + fq * 8, qw0); ld8f(p->q_norm_w + 32 + fq * 8, qw1);
    u32x4 qn0, qn1;
    { const bf16* qp = proj + (size_t)(b * SEQ + c * 128 + (wave & 1) * 64 + fr) * N1 + h * 64 + fq * 8; qn0 = *(const u32x4*)qp; qn1 = *(const u32x4*)(qp + 32); }
    for (int it = 0; it < 4; ++it) {
        int oz = 0; asm volatile("" : "+v"(oz));
        const LAS bf16* Ksi = Ks + oz; const LAS bf16* Vti = Vt + oz;
        const int qi = (wave & 1) * 64 + it * 16 + fr;
        const size_t qrow = (size_t)(b * SEQ + c * 128 + qi);
        float q0[8], q1[8]; unpack8(qn0, q0); unpack8(qn1, q1);
        { const int itn = it < 3 ? it + 1 : 3;
          const bf16* qp = proj + (size_t)(b * SEQ + c * 128 + (wave & 1) * 64 + itn * 16 + fr) * N1 + h * 64 + fq * 8; qn0 = *(const u32x4*)qp; qn1 = *(const u32x4*)(qp + 32); }
        float ss = 0.f;
#pragma unroll
        for (int e = 0; e < 8; ++e) ss += q0[e] * q0[e] + q1[e] * q1[e];
        ss += __shfl_xor(ss, 16); ss += __shfl_xor(ss, 32);
        const float rs = rsqrtf(ss * (1.f / 64.f) + EPS) * 0.125f;
#pragma unroll
        for (int e = 0; e < 8; ++e) { q0[e] = q0[e] * rs * qw0[e]; q1[e] = q1[e] * rs * qw1[e]; }
        const bf16x8 qb0 = __builtin_bit_cast(bf16x8, pack8m(q0)), qb1 = __builtin_bit_cast(bf16x8, pack8m(q1));
        f32x4 S[16];
#pragma unroll
        for (int T = 0; T < 16; ++T) {
            S[T] = (f32x4){0.f, 0.f, 0.f, 0.f};
            const LAS bf16* kp = Ksi + (T * 16 + fr) * 72 + fq * 8;
            S[T] = __builtin_amdgcn_mfma_f32_16x16x32_bf16(*(const LAS bf16x8*)kp, qb0, S[T], 0, 0, 0);
            S[T] = __builtin_amdgcn_mfma_f32_16x16x32_bf16(*(const LAS bf16x8*)(kp + 32), qb1, S[T], 0, 0, 0);
        }
        float mx = sink;
#pragma unroll
        for (int T = 0; T < 16; ++T)
#pragma unroll
            for (int r = 0; r < 4; ++r) {
                const int j = T * 16 + fq * 4 + r, dist = 128 + qi - j;
                const bool valid = (dist >= 0) && (dist <= 128) && (c > 0 || j >= 128);
                const float s = valid ? S[T][r] - slope * (float)dist : -1e30f;
                S[T][r] = s; mx = fmaxf(mx, s);
            }
        mx = fmaxf(mx, __shfl_xor(mx, 16)); mx = fmaxf(mx, __shfl_xor(mx, 32));
        float sum = 0.f;
#pragma unroll
        for (int T = 0; T < 16; ++T)
#pragma unroll
            for (int r = 0; r < 4; ++r) { const float pv = __expf(S[T][r] - mx); S[T][r] = pv; sum += pv; }
        sum += __shfl_xor(sum, 16); sum += __shfl_xor(sum, 32);
        sum += __expf(sink - mx);
        f32x4 O[4];
#pragma unroll
        for (int dt = 0; dt < 4; ++dt) O[dt] = (f32x4){0.f, 0.f, 0.f, 0.f};
#pragma unroll
        for (int s = 0; s < 8; ++s) {
            u32x4 pw; pw.x = pk2m(S[2 * s][0], S[2 * s][1]); pw.y = pk2m(S[2 * s][2], S[2 * s][3]); pw.z = pk2m(S[2 * s + 1][0], S[2 * s + 1][1]); pw.w = pk2m(S[2 * s + 1][2], S[2 * s + 1][3]);
            const bf16x8 pb = __builtin_bit_cast(bf16x8, pw);
#pragma unroll
            for (int dt = 0; dt < 4; ++dt) {
                const LAS bf16* vp = Vti + (dt * 16 + fr) * 264 + s * 32 + fq * 4;
                const u32x2 lo = *(const LAS u32x2*)vp, hi = *(const LAS u32x2*)(vp + 16);
                u32x4 vv; vv.x = lo.x; vv.y = lo.y; vv.z = hi.x; vv.w = hi.y;
                O[dt] = __builtin_amdgcn_mfma_f32_16x16x32_bf16(__builtin_bit_cast(bf16x8, vv), pb, O[dt], 0, 0, 0);
            }
        }
        const float inv = 1.f / sum;
#pragma unroll
        for (int dt = 0; dt < 4; ++dt) { u32x2 o; o.x = pk2(O[dt][0] * inv, O[dt][1] * inv); o.y = pk2(O[dt][2] * inv, O[dt][3] * inv);
            *(u32x2*)(mix + qrow * DM + h * 64 + dt * 16 + fq * 4) = o; }
    }
    __syncthreads();
}

__device__ __forceinline__ void sgu_prompt_unit(LAS unsigned char* lds, KP p, const bf16* proj, bf16* mix, int unit) {
    const int tid = tid_fresh(), wave = tid >> 6, lane = tid & 63, fr = lane & 15, fq = lane >> 4;
    const int g = unit & 3, c = (unit >> 2) & 15, b = unit >> 6;
    LAS bf16* vnT = (LAS bf16*)lds;
    LAS bf16* Wl = (LAS bf16*)(lds + 69632);
#pragma unroll
    for (int i = 0; i < 8; ++i) {
        const int id = tid + 512 * i, t = id >> 5, s4 = (id & 31) * 4;
        const f32x4 w = *(const f32x4*)(p->sgu_w + (size_t)(g * 128 + t) * 128 + s4);
        u32x2 o; o.x = pk2(s4 <= t ? w.x : 0.f, s4 + 1 <= t ? w.y : 0.f); o.y = pk2(s4 + 2 <= t ? w.z : 0.f, s4 + 3 <= t ? w.w : 0.f);
        *(LAS u32x2*)(Wl + t * 136 + s4) = o;
    }
    float nw[16];
    { float a[8], bq[8]; ld8f(p->sgu_norm_w + lane * 16, a); ld8f(p->sgu_norm_w + lane * 16 + 8, bq);
#pragma unroll
      for (int e = 0; e < 8; ++e) { nw[e] = a[e]; nw[8 + e] = bq[e]; } }
    for (int r8 = 0; r8 < 16; r8 += 8) {
        const int s0 = wave * 16 + r8;
        float x[8][16];
#pragma unroll
        for (int q = 0; q < 8; ++q) {
            const bf16* gp = proj + (size_t)(b * SEQ + c * 128 + s0 + q) * N1 + C_GV + lane * 16;
            const u32x4 ua = *(const u32x4*)gp, ub = *(const u32x4*)(gp + 8);
            float a[8], bq[8]; unpack8(ua, a); unpack8(ub, bq);
#pragma unroll
            for (int e = 0; e < 8; ++e) { x[q][e] = a[e]; x[q][8 + e] = bq[e]; }
        }
        float mean[8], rstd[8];
#pragma unroll
        for (int q = 0; q < 8; ++q) { float sm = 0.f;
#pragma unroll
            for (int e = 0; e < 16; ++e) sm += x[q][e];
            mean[q] = wave_sum(sm) * (1.f / 1024.f); }
#pragma unroll
        for (int q = 0; q < 8; ++q) { float sq = 0.f;
#pragma unroll
            for (int e = 0; e < 16; ++e) { x[q][e] -= mean[q]; sq += x[q][e] * x[q][e]; }
            rstd[q] = rsqrtf(wave_sum(sq) * (1.f / 1024.f) + EPS); }
        if (fq == g) {
#pragma unroll
            for (int q = 0; q < 8; ++q) {
#pragma unroll
                for (int e = 0; e < 16; ++e) x[q][e] = x[q][e] * rstd[q] * nw[e];
                if (c == 15) { float* o = p->out + OFF_GP + ((size_t)(b * 128 + s0 + q)) * 1024 + lane * 16;
#pragma unroll
                    for (int e4 = 0; e4 < 4; ++e4) *(f32x4*)(o + 4 * e4) = (f32x4){x[q][4 * e4], x[q][4 * e4 + 1], x[q][4 * e4 + 2], x[q][4 * e4 + 3]}; }
            }
#pragma unroll
            for (int e = 0; e < 16; ++e) {
                u32x4 w; w.x = pk2(x[0][e], x[1][e]); w.y = pk2(x[2][e], x[3][e]); w.z = pk2(x[4][e], x[5][e]); w.w = pk2(x[6][e], x[7][e]);
                *(LAS u32x4*)(vnT + (fr * 16 + e) * 136 + s0) = w;
            }
        }
    }
    __syncthreads();
    f32x4 acc[8][2];
#pragma unroll
    for (int tt = 0; tt < 8; ++tt) { acc[tt][0] = (f32x4){0.f, 0.f, 0.f, 0.f}; acc[tt][1] = (f32x4){0.f, 0.f, 0.f, 0.f}; }
#pragma unroll
    for (int ks = 0; ks < 4; ++ks) {
        const bf16x8 a0 = *(const LAS bf16x8*)(vnT + (wave * 32 + fr) * 136 + ks * 32 + fq * 8);
        const bf16x8 a1 = *(const LAS bf16x8*)(vnT + (wave * 32 + 16 + fr) * 136 + ks * 32 + fq * 8);
#pragma unroll
        for (int tt = 2 * ks; tt < 8; ++tt) {
            const bf16x8 bw = *(const LAS bf16x8*)(Wl + (tt * 16 + fr) * 136 + ks * 32 + fq * 8);
            acc[tt][0] = __builtin_amdgcn_mfma_f32_16x16x32_bf16(a0, bw, acc[tt][0], 0, 0, 0);
            acc[tt][1] = __builtin_amdgcn_mfma_f32_16x16x32_bf16(a1, bw, acc[tt][1], 0, 0, 0);
        }
    }
#pragma unroll
    for (int tt = 0; tt < 8; ++tt) {
        const int t = tt * 16 + fr; const size_t row = (size_t)(b * SEQ + c * 128 + t);
        const float bias = p->sgu_b[g * 128 + t];
#pragma unroll
        for (int ct = 0; ct < 2; ++ct) {
            const int ch = g * 256 + wave * 32 + ct * 16 + fq * 4;
            const u32x2 gu = *(const u32x2*)(proj + row * N1 + C_GU + ch);
            u32x2 o; o.x = pk2((acc[tt][ct][0] + bias) * bf_lo(gu.x), (acc[tt][ct][1] + bias) * bf_hi(gu.x));
            o.y = pk2((acc[tt][ct][2] + bias) * bf_lo(gu.y), (acc[tt][ct][3] + bias) * bf_hi(gu.y));
            *(u32x2*)(mix + row * DM + 1024 + ch) = o;
        }
    }
    __syncthreads();
}

__device__ __forceinline__ void sample_attn_item(LAS float* wl  , KP p, const bf16* proj, bf16* mix, int item, int lane) {
    const int h = item & 15, b = item >> 4, kh = h >> 2;
    const bf16* rp = proj + (size_t)(MP + b) * N1;
    float q = bf_lo((unsigned)rp[h * 64 + lane]), kn = bf_lo((unsigned)rp[C_K + kh * 64 + lane]), vn = bf_lo((unsigned)rp[C_V + kh * 64 + lane]);
    q = q * rsqrtf(wave_sum(q * q) * (1.f / 64.f) + EPS) * p->q_norm_w[lane] * 0.125f;
    kn = kn * rsqrtf(wave_sum(kn * kn) * (1.f / 64.f) + EPS) * p->k_norm_w[lane];
    const float slope = exp2f(-0.5f * (float)(h + 1)), sink = p->sinks[h];
    wl[lane] = q;
    asm volatile("s_waitcnt lgkmcnt(0)" ::: "memory");
    const float* kb = p->st_k + ((size_t)b * 128 * 4 + kh) * 64;
    float s0 = 0.f, s1 = 0.f;
    { const float* k0 = kb + (size_t)lane * 256; const float* k1 = kb + (size_t)(lane + 64) * 256;
#pragma unroll
      for (int d = 0; d < 64; d += 4) { const f32x4 a = *(const f32x4*)(k0 + d), c4 = *(const f32x4*)(k1 + d);
          const float w0 = wl[d], w1 = wl[d + 1], w2 = wl[d + 2], w3 = wl[d + 3];
          s0 += a.x * w0 + a.y * w1 + a.z * w2 + a.w * w3; s1 += c4.x * w0 + c4.y * w1 + c4.z * w2 + c4.w * w3; } }
    const float* vb = p->st_v + ((size_t)b * 128 * 4 + kh) * 64 + lane;
    float vv[128];
#pragma unroll
    for (int j = 0; j < 128; ++j) vv[j] = vb[(size_t)j * 256];
    s0 -= slope * (float)(128 - lane); s1 -= slope * (float)(64 - lane);
    const float sn = wave_sum(q * kn);
    const float mx = fmaxf(fmaxf(wave_max(fmaxf(s0, s1)), sn), sink);
    const float p0 = __expf(s0 - mx), p1 = __expf(s1 - mx), pn = __expf(sn - mx);
    const float den = wave_sum(p0 + p1) + pn + __expf(sink - mx);
    wl[64 + lane] = p0; wl[128 + lane] = p1;
    asm volatile("s_waitcnt lgkmcnt(0)" ::: "memory");
    float o = pn * vn;
#pragma unroll
    for (int j = 0; j < 128; ++j) o += wl[64 + j] * vv[j];
    mix[(size_t)(MP + b) * DM + h * 64 + lane] = (bf16)(pk2(o / den, 0.f) & 0xffffu);
    if ((h & 3) == 0) p->out[OFF_KS + ((size_t)(b * 128 + 127) * 4 + kh) * 64 + lane] = kn;
    asm volatile("s_waitcnt lgkmcnt(0)" ::: "memory");
}
__device__ __forceinline__ void sample_sgu_item(KP p, const bf16* proj, bf16* mix, int b, int lane) {
    const bf16* rp = proj + (size_t)(MP + b) * N1;
    float x[16];
    { float a[8], bq[8]; unpack8(*(const u32x4*)(rp + C_GV + lane * 16), a); unpack8(*(const u32x4*)(rp + C_GV + lane * 16 + 8), bq);
#pragma unroll
      for (int e = 0; e < 8; ++e) { x[e] = a[e]; x[8 + e] = bq[e]; } }
    float sm = 0.f;
#pragma unroll
    for (int e = 0; e < 16; ++e) sm += x[e];
    const float mean = wave_sum(sm) * (1.f / 1024.f);
    float sq = 0.f;
#pragma unroll
    for (int e = 0; e < 16; ++e) { x[e] -= mean; sq += x[e] * x[e]; }
    const float rstd = rsqrtf(wave_sum(sq) * (1.f / 1024.f) + EPS);
    const int g = lane >> 4;
    const float w00 = p->sgu_w[(size_t)g * 128 * 128], b0 = p->sgu_b[g * 128];
    float gu[16];
    { float a[8], bq[8]; unpack8(*(const u32x4*)(rp + C_GU + lane * 16), a); unpack8(*(const u32x4*)(rp + C_GU + lane * 16 + 8), bq);
#pragma unroll
      for (int e = 0; e < 8; ++e) { gu[e] = a[e]; gu[8 + e] = bq[e]; } }
    float o8[8], o9[8];
#pragma unroll
    for (int e = 0; e < 16; ++e) {
        const float vn = x[e] * rstd * p->sgu_norm_w[lane * 16 + e];
        p->out[OFF_GS + (size_t)b * 1024 + lane * 16 + e] = vn;
        const float r = gu[e] * (w00 * vn + b0);
        if (e < 8) o8[e] = r; else o9[e - 8] = r;
    }
    *(u32x4*)(mix + (size_t)(MP + b) * DM + 1024 + lane * 16) = pack8(o8);
    *(u32x4*)(mix + (size_t)(MP + b) * DM + 1024 + lane * 16 + 8) = pack8(o9);
}

__device__ __forceinline__ void p2_phase(LAS unsigned char* lds, KP p, const bf16* proj, bf16* mix) {
    const int G = gridDim.x;
    for (int u = blockIdx.x; u < 256; u += G) attn_prompt_unit(lds, p, proj, mix, u);
    for (int u = blockIdx.x; u < 256; u += G) sgu_prompt_unit(lds, p, proj, mix, u);
    const int tid = tid_fresh(), lane = tid & 63, wave = tid >> 6, gw = blockIdx.x * 8 + wave, NGW = G * 8;
    LAS float* wl = (LAS float*)lds + wave * 256;
    for (int it = gw; it < 512 + 32; it += NGW) {
        if (it < 512) sample_attn_item(wl, p, proj, mix, it, lane);
        else sample_sgu_item(p, proj, mix, it - 512, lane);
    }
    for (int idx = blockIdx.x * 512 + tid; idx < MS * 127 * 64; idx += G * 512) {
        const int bb = idx / (127 * 64), rem = idx - bb * (127 * 64), j = rem >> 6, c4 = (rem & 63) * 4;
        const size_t src = ((size_t)(bb * 128 + j + 1)) * 256 + c4, dst = ((size_t)(bb * 128 + j)) * 256 + c4;
        *(f32x4*)(p->out + OFF_KS + dst) = *(const f32x4*)(p->st_k + src);
        *(f32x4*)(p->out + OFF_VS + dst) = *(const f32x4*)(p->st_v + src);
    }
    __syncthreads();
    {
        constexpr int FIRST = (512 + MS + 7) / 8;
        const int f = ((int)gridDim.x > 2 * FIRST) ? FIRST : 0;
        if ((int)blockIdx.x >= f) convert_items(lds, p, I_EARLY, I_MID, ((int)blockIdx.x - f) * 8 + __builtin_amdgcn_readfirstlane(wave), ((int)gridDim.x - f) * 8, __builtin_amdgcn_readfirstlane(wave), lane);
    }
    __syncthreads();
}

__device__ __forceinline__ void conv_fix_phase(KP p, const float* hb, const float* hs, bf16* act) {
    const int NT = gridDim.x * 512;
    constexpr int NCG = DFF / 8, NPR = 28 * 2;
    for (int it = blockIdx.x * 512 + tid_fresh(); it < NCG * (NPR + MS); it += NT) {
        const int cgp = it % NCG, ri = it / NCG, ch = cgp * 8, colg = (ch >> 7) * 256 + (ch & 127), colu = colg + 128;
        float wg0[8], wg1[8], wg2[8], bg[8], wu0[8], wu1[8], wu2[8], bu[8];
        ld8f(p->conv_w + ch, wg0); ld8f(p->conv_w + NUP + ch, wg1); ld8f(p->conv_w + 2 * NUP + ch, wg2); ld8f(p->conv_b + ch, bg);
        ld8f(p->conv_w + DFF + ch, wu0); ld8f(p->conv_w + NUP + DFF + ch, wu1); ld8f(p->conv_w + 2 * NUP + DFF + ch, wu2); ld8f(p->conv_b + DFF + ch, bu);
        float g2[8], g1[8], g0[8], u2[8], u1[8], u0[8], o[8];
        size_t orow;
        if (ri < NPR) {
            const int k = ri >> 1, rr = ri & 1, pm = (k / 7) * 8 + (k % 7) + 1;
            const float* h2 = rr == 0 ? hb + ((size_t)((pm - 1) * 4 + 2)) * NUP : hb + ((size_t)((pm - 1) * 4 + 3)) * NUP;
            const float* h1 = rr == 0 ? hb + ((size_t)((pm - 1) * 4 + 3)) * NUP : hb + ((size_t)(pm * 4 + 0)) * NUP;
            const float* h0 = hb + ((size_t)(pm * 4 + rr)) * NUP;
            ld8f(h2 + colg, g2); ld8f(h1 + colg, g1); ld8f(h0 + colg, g0); ld8f(h2 + colu, u2); ld8f(h1 + colu, u1); ld8f(h0 + colu, u0);
            orow = (size_t)pm * 256 + rr;
        } else {
            const int bb = ri - NPR;
            const float* st = p->st_conv + (size_t)bb * 2 * NUP;
            ld8f(st + ch, g2); ld8f(st + NUP + ch, g1); ld8f(st + DFF + ch, u2); ld8f(st + NUP + DFF + ch, u1);
            ld8f(hs + (size_t)bb * NUP + colg, g0); ld8f(hs + (size_t)bb * NUP + colu, u0);
            st8f(p->out + OFF_CS + (size_t)bb * 2 * NUP + ch, g1); st8f(p->out + OFF_CS + (size_t)bb * 2 * NUP + DFF + ch, u1);
            orow = (size_t)MP + bb;
        }
#pragma unroll
        for (int e = 0; e < 8; ++e) {
            const float hg = wg0[e] * g2[e] + wg1[e] * g1[e] + wg2[e] * g0[e] + bg[e];
            const float hu = wu0[e] * u2[e] + wu1[e] * u1[e] + wu2[e] * u0[e] + bu[e];
            o[e] = silu_(hg) * hu;
        }
        *(u32x4*)(act + orow * DFF + ch) = pack8(o);
    }
}

__device__ __forceinline__ void bubble_convert(LAS unsigned char* lds, KP p, int first, int lo, int hi) {
    if ((int)blockIdx.x < first) return;
    const int tid = tid_fresh(), lane = tid & 63, wave = __builtin_amdgcn_readfirstlane(tid >> 6);
    convert_items(lds, p, lo, hi, ((int)blockIdx.x - first) * 8 + wave, ((int)gridDim.x - first) * 8, wave, lane);
    __syncthreads();
}
#define XB_TMO      128
#define XB_XCNT(j)  (256  + 64 * (j))
#define XB_XSUB(j)  (1280 + 64 * (j))
#define XB_XGEN(j)  (2304 + 64 * (j))
#define XB_TOP      3328
#define XB_TOPGEN   3392
#define XCD_BAR_WORDS 3456
#define XB_SPIN_CAP (1u << 18)

__device__ __forceinline__ unsigned xb_ld(unsigned* p)              { return __hip_atomic_load(p, __ATOMIC_RELAXED, __HIP_MEMORY_SCOPE_AGENT); }
__device__ __forceinline__ unsigned xb_add(unsigned* p, unsigned v) { return __hip_atomic_fetch_add(p, v, __ATOMIC_RELAXED, __HIP_MEMORY_SCOPE_AGENT); }
__device__ __forceinline__ unsigned xb_xcc_id() { return (unsigned)__builtin_amdgcn_s_getreg((3 << 11) | 20) & 0xFu; }
#define XB_SPIN(cond, bar) do { unsigned _sp = 0; while (cond) { __builtin_amdgcn_s_sleep(1); \
    if ((++_sp & 255u) == 0u) { if (xb_ld(&(bar)[XB_TMO])) break; if (_sp > XB_SPIN_CAP) { atomicAdd(&(bar)[XB_TMO], 1u); break; } } } } while (0)

struct XcdBarrier {
    unsigned* bar; unsigned x;
    volatile LAS unsigned* st;
};

__device__ __forceinline__ XcdBarrier xcd_barrier_post(unsigned* bar, volatile LAS unsigned* st) {
    XcdBarrier b; b.bar = bar; b.x = xb_xcc_id(); b.st = st;
    if (threadIdx.x == 0) (void)xb_add(&bar[XB_XCNT(b.x)], 1u);
    return b;
}
__device__ __forceinline__ void xcd_barrier_complete(unsigned* bar, unsigned x, unsigned& nloc, unsigned& nx) {
    const unsigned G = gridDim.x * gridDim.y * gridDim.z;
    unsigned sum, cnt, mine, sp = 0u;
    for (;;) {
        sum = 0u; cnt = 0u; mine = 0u;
#pragma unroll
        for (unsigned j = 0; j < 16; ++j) { const unsigned c = xb_ld(&bar[XB_XCNT(j)]); sum += c; cnt += (c > 0u) ? 1u : 0u; mine = (j == x) ? c : mine; }
        if (sum == G) break;
        __builtin_amdgcn_s_sleep(1);
        if ((++sp & 255u) == 0u) { if (xb_ld(&bar[XB_TMO])) break; if (sp > XB_SPIN_CAP) { atomicAdd(&bar[XB_TMO], 1u); break; } }
    }
    nloc = mine > 0u ? mine : 1u; nx = cnt > 0u ? cnt : 1u;
}

__device__ __forceinline__ void xcd_barrier(const XcdBarrier& b) {
    asm volatile("s_waitcnt vmcnt(0)" ::: "memory");
    __syncthreads();
    if (threadIdx.x == 0) {
        unsigned* bar = b.bar;
        __builtin_amdgcn_s_waitcnt(0);
        unsigned nloc = b.st[0], nx = b.st[1];
        if (nloc == 0u) { xcd_barrier_complete(bar, b.x, nloc, nx); b.st[0] = nloc; b.st[1] = nx; }
        const unsigned old = xb_add(&bar[XB_XSUB(b.x)], 1u);
        const unsigned gen = old / nloc;
        if (old + 1u == (gen + 1u) * nloc) {
            __builtin_amdgcn_fence(__ATOMIC_RELEASE, "agent");
            asm volatile("s_waitcnt vmcnt(0)" ::: "memory");
            const unsigned og = xb_add(&bar[XB_TOP], 1u);
            const unsigned tg = og / nx;
            if (og + 1u == (tg + 1u) * nx) xb_add(&bar[XB_TOPGEN], 1u);
            else XB_SPIN(xb_ld(&bar[XB_TOPGEN]) == tg, bar);
            __builtin_amdgcn_fence(__ATOMIC_ACQUIRE, "agent");
            xb_add(&bar[XB_XGEN(b.x)], 1u);
            asm volatile("s_waitcnt vmcnt(0)" ::: "memory");
        } else {
            XB_SPIN(xb_ld(&bar[XB_XGEN(b.x)]) == gen, bar);
            __builtin_amdgcn_fence(__ATOMIC_ACQUIRE, "agent");
            asm volatile("s_waitcnt vmcnt(0)" ::: "memory");
        }
    }
    __syncthreads();
}


__global__ void __launch_bounds__(512, 2) fwd_mega(Params p_unused) {
    extern __shared__ __attribute__((aligned(16))) unsigned char lds_raw[];
    LAS unsigned char* lds = (LAS unsigned char*)lds_raw;
    cg::grid_group grid = cg::this_grid();
    if (threadIdx.x < 64) ((LAS unsigned*)(lds + MISC_OFF))[threadIdx.x] = 0u;
    __syncthreads();
    if (gridDim.x > 65535u) grid.sync();
    { KP p = kargs(); (void)xcd_barrier_post((unsigned*)(p->ws + WS_BAR), (volatile LAS unsigned*)(lds + MISC_OFF)); }
#define WSP(T, off) ((T*)(ws + (off)))
#define XSYNC() do { KP p_ = kargs(); XcdBarrier b_; b_.bar = (unsigned*)(p_->ws + WS_BAR); b_.x = xb_xcc_id(); b_.st = (volatile LAS unsigned*)(lds + MISC_OFF); xcd_barrier(b_); } while (0)
#define REP(k) for (int rep_ = 0; rep_ < ((DUP_PHASE == (k)) ? 2 : 1); ++rep_)
    REP(0) { KP p = kargs(); p0_phase(lds, p); }
    XSYNC();
    REP(1) { KP p = kargs(); unsigned char* ws = p->ws; E1 e{WSP(bf16, WS_PROJ), p->b_gate, p->out};
      big_gemm(lds, WSP(bf16, WS_XN), DM, WSP(bf16, WS_W1), DM, N1, DM, e); small_gemm(lds, WSP(bf16, WS_XN) + (size_t)MP * DM, DM, WSP(bf16, WS_W1), DM, N1, DM, e);
      bubble_convert(lds, p, (MP / 256 * (N1 / 256)) % (int)gridDim.x, I_MID, I_MID + I_UP); }
    XSYNC();
    REP(2) { KP p = kargs(); unsigned char* ws = p->ws; p2_phase(lds, p, WSP(bf16, WS_PROJ), WSP(bf16, WS_MIX)); }
    XSYNC();
    { KP p = kargs(); unsigned char* ws = p->ws;
      EpiMerge em{WSP(bf16, WS_PROJ), WSP(bf16, WS_MERGED)};
      pg8::Gemm g{WSP(bf16, WS_MIX), WSP(bf16, WS_WBA), MP, DM, DM, DM, DM}; pg8::StaticOrder S; S.init(MP, DM, (int)gridDim.x, (int)blockIdx.x);
      pg8::gemm_phase<EpiMerge, pg8::StaticOrder, true, true>(lds, g, S, em);
      E2s es{WSP(bf16, WS_PROJ), WSP(bf16, WS_MERGED)};
      small_gemm_dual(lds, WSP(bf16, WS_MIX) + (size_t)MP * DM, DM, WSP(bf16, WS_WBA), DM, DM, es); }
    XSYNC();
    REP(4) { KP p = kargs(); unsigned char* ws = p->ws; E3 e{p->x_prompt, p->x_sample, (bf16*)(p->out + OFF_Y), p->ffn_norm_w, WSP(bf16, WS_XN), WSP(float, WS_SS1)};
      big_gemm(lds, WSP(bf16, WS_MERGED), DM, WSP(bf16, WS_WOUT), DM, DM, DM, e); small_gemm(lds, WSP(bf16, WS_MERGED) + (size_t)MP * DM, DM, WSP(bf16, WS_WOUT), DM, DM, DM, e); }
    XSYNC();
    { KP p = kargs(); unsigned char* ws = p->ws;
      EpiConv ec{WSP(bf16, WS_ACT), p->out, WSP(float, WS_SS1), p->conv_w, p->conv_b, WSP(float, WS_HB), (LAS float*)(lds + 131072)};
      pg8::Gemm g{WSP(bf16, WS_XN), WSP(bf16, WS_WUP), MP, NUP, DM, DM, DM}; pg8::StaticOrder S; S.init(MP, NUP, (int)gridDim.x, (int)blockIdx.x);
      pg8::gemm_phase<EpiConv, pg8::StaticOrder, true, true>(lds, g, S, ec);
      E4s e{WSP(float, WS_HS), p->out, WSP(float, WS_SS1)};
      small_gemm(lds, WSP(bf16, WS_XN) + (size_t)MP * DM, DM, WSP(bf16, WS_WUP), DM, NUP, DM, e);
      const int first6 = (MP / 256 * (NUP / 256)) % (int)gridDim.x;
      bubble_convert(lds, p, first6, I_MID + I_UP, NITEMS);
      if ((int)blockIdx.x >= first6) {
          E6a e6{WSP(bf16, WS_PP)}; EpiAd<E6a> E{e6};
          pg8::Gemm g2{WSP(bf16, WS_PBF), WSP(bf16, WS_WPP), MP, DM, PLE, PLE, PLE}; pg8::StaticOrder S2; S2.init(MP, DM, (int)gridDim.x - first6, (int)blockIdx.x - first6);
          pg8::gemm_phase<EpiAd<E6a>, pg8::StaticOrder, true, true>(lds, g2, S2, E);
      }
      { E6a e6{WSP(bf16, WS_PP)}; small_gemm(lds, WSP(bf16, WS_PBF) + (size_t)MP * PLE, PLE, WSP(bf16, WS_WPP), PLE, DM, PLE, e6); } }
    XSYNC();
    { KP p = kargs(); unsigned char* ws = p->ws; conv_fix_phase(p, WSP(float, WS_HB), WSP(float, WS_HS), WSP(bf16, WS_ACT)); }
    XSYNC();
    { KP p = kargs(); unsigned char* ws = p->ws; E5 e{(const bf16*)(p->out + OFF_Y), WSP(bf16, WS_XN), p->ple_norm_w, WSP(bf16, WS_XN3), WSP(float, WS_SS2)};
      big_gemm(lds, WSP(bf16, WS_ACT), DFF, WSP(bf16, WS_WDOWN), DFF, DM, DFF, e); small_gemm(lds, WSP(bf16, WS_ACT) + (size_t)MP * DFF, DFF, WSP(bf16, WS_WDOWN), DFF, DM, DFF, e); }
    XSYNC();
    { KP p = kargs(); unsigned char* ws = p->ws; E6b e{WSP(bf16, WS_PP), WSP(bf16, WS_XN), p->out + OFF_Y, WSP(float, WS_SS2)};
      big_gemm(lds, WSP(bf16, WS_XN3), DM, WSP(bf16, WS_WPG), DM, DM, DM, e); small_gemm(lds, WSP(bf16, WS_XN3) + (size_t)MP * DM, DM, WSP(bf16, WS_WPG), DM, DM, DM, e); }
#undef WSP
}

extern "C" void kernel_launch(void* const* d_in, const int* in_sizes, int n_in, void* d_out, int out_size, void* d_ws, size_t ws_size, hipStream_t stream) {
    static int grid = 0;
    if (grid == 0) {
        if (n_in != 28 || out_size != (int)OUT_TOTAL || ws_size < WS_END) { fprintf(stderr, "kernel_launch: unexpected shapes: n_in %d out %d ws %zu\n", n_in, out_size, ws_size); grid = -1; return; }
        int dev = 0, cus = 0, per_cu = 0;
        (void)hipGetDevice(&dev); (void)hipDeviceGetAttribute(&cus, hipDeviceAttributeMultiprocessorCount, dev);
        if (hipFuncSetAttribute((const void*)fwd_mega, hipFuncAttributeMaxDynamicSharedMemorySize, LDS_BYTES) != hipSuccess) { fprintf(stderr, "kernel_launch: hipFuncSetAttribute failed\n"); grid = -1; return; }
        if (hipOccupancyMaxActiveBlocksPerMultiprocessor(&per_cu, (const void*)fwd_mega, 512, LDS_BYTES) != hipSuccess || per_cu < 1) { fprintf(stderr, "kernel_launch: occupancy query says %d\n", per_cu); per_cu = 1; }
        (void)hipGetLastError();
        grid = cus * 1;
    }
    if (grid < 0) return;
    Params p{};
    const float** pp = (const float**)&p;
    for (int i = 0; i < 28; ++i) pp[i] = (const float*)d_in[i];
    p.out = (float*)d_out; p.ws = (unsigned char*)d_ws;
    if (hipMemsetAsync((char*)d_ws + WS_BAR, 0, XCD_BAR_WORDS * 4, stream) != hipSuccess) { fprintf(stderr, "kernel_launch: memset of the barrier words failed\n"); return; }
    void* args[] = {&p};
    hipError_t e = hipLaunchCooperativeKernel((const void*)fwd_mega, dim3(grid), dim3(512), args, LDS_BYTES, stream);
    if (e != hipSuccess) fprintf(stderr, "kernel_launch: cooperative launch failed: %s (grid %d)\n", hipGetErrorString(e), grid);
}
```

```cpp
#include <hip/hip_runtime.h>
#include <hip/hip_cooperative_groups.h>
#include <cstdio>
#include <cstdint>
namespace cg = cooperative_groups;

#define LAS __attribute__((address_space(3)))
typedef unsigned short bf16;
typedef unsigned u32x4 __attribute__((ext_vector_type(4)));
typedef unsigned u32x2 __attribute__((ext_vector_type(2)));
typedef float f32x4 __attribute__((ext_vector_type(4)));
typedef short bf16x8 __attribute__((ext_vector_type(8)));

constexpr int DM = 2048, MP = 8192, MS = 32, MALL = MP + MS, SEQ = 2048;
constexpr int N1 = 7680, DFF = 5632, NUP = 11264, PLE = 256;
constexpr int C_K = 1024, C_V = 1280, C_GU = 1536, C_GV = 2560, C_GATE = 3584;
constexpr float EPS = 1e-6f;
constexpr size_t OFF_Y = 0, OFF_KP = 16842752, OFF_VP = 16973824, OFF_KS = 17104896, OFF_VS = 18153472,
                 OFF_GP = 19202048, OFF_GS = 19726336, OFF_CP = 19759104, OFF_CS = 19849216, OUT_TOTAL = 20570112;
constexpr size_t MiB = 1u << 20;
constexpr size_t WS_WUP = 1 * MiB, WS_WDOWN = 45 * MiB, WS_WPG = 67 * MiB, WS_WPP = 75 * MiB, WS_XN = 76 * MiB;
constexpr size_t WS_W1 = 109 * MiB, WS_WBA = 139 * MiB, WS_WBG = 143 * MiB, WS_WOUT = 147 * MiB;
constexpr size_t WS_PROJ = 155 * MiB, WS_MIX = 276 * MiB, WS_MERGED = 309 * MiB, WS_PBF = 342 * MiB;
constexpr size_t WS_BAR = 262144;
constexpr size_t WS_SS1 = 0, WS_SS2 = 65536, WS_XN3 = 254 * MiB, WS_HB = 109 * MiB, WS_HS = 116 * MiB;
constexpr size_t WS_ACT = 165 * MiB, WS_PP = 118 * MiB, WS_END = 347 * MiB;
static_assert(WS_PROJ + (size_t)MALL * N1 * 2 <= WS_MIX && WS_MIX + (size_t)MALL * 2048 * 2 <= WS_MERGED && WS_MERGED + (size_t)MALL * 2048 * 2 <= WS_PBF, "ws map early");
static_assert(WS_ACT + (size_t)MALL * DFF * 2 <= WS_XN3 && WS_XN3 + (size_t)MALL * DM * 2 <= WS_PBF && WS_PBF + (size_t)MALL * PLE * 2 <= WS_END && WS_PP + (size_t)MALL * DM * 2 <= WS_ACT && WS_HS + (size_t)MS * NUP * 4 <= WS_PP && WS_HB + (size_t)32 * 4 * NUP * 4 <= WS_HS && WS_HS + (size_t)MS * NUP * 4 <= WS_ACT, "ws map late");
constexpr int MISC_OFF = 131072 + 8192;
constexpr int WL_OFF = 131072 + 8192 + 256, RSL_OFF = WL_OFF + 4096;
constexpr int LDS_BYTES = RSL_OFF + 1024;
#ifndef DUP_PHASE
#define DUP_PHASE -1
#endif

struct Params {
    const float *x_prompt, *x_sample, *p_prompt, *p_sample, *st_k, *st_v, *st_conv;
    const float *attn_norm_w, *w_in, *q_norm_w, *k_norm_w, *sinks, *sgu_norm_w, *sgu_w, *sgu_b;
    const float *w_br_attn, *w_br_gm, *w_gate, *b_gate, *w_out, *ffn_norm_w, *w_up, *conv_w, *conv_b, *w_down, *ple_norm_w, *w_ple_gate, *w_ple_proj;
    float* out; unsigned char* ws;
};

typedef const __attribute__((address_space(4))) Params* KP;
__device__ __forceinline__ KP kargs() { KP k = (KP)__builtin_amdgcn_kernarg_segment_ptr(); asm volatile("" : "+s"(k)); return k; }

__device__ __forceinline__ int tid_fresh() { int t = threadIdx.x; asm volatile("" : "+v"(t)); return t; }
typedef float f32x2_t __attribute__((ext_vector_type(2)));
typedef __bf16 bf16x2_t __attribute__((ext_vector_type(2)));
__device__ __forceinline__ unsigned pk2m(float lo, float hi) { f32x2_t v = {lo, hi}; bf16x2_t b = __builtin_convertvector(v, bf16x2_t); return __builtin_bit_cast(unsigned, b); }
__device__ __forceinline__ unsigned pk2(float lo, float hi) { unsigned r; asm("v_cvt_pk_bf16_f32 %0, %1, %2" : "=v"(r) : "v"(lo), "v"(hi)); return r; }
__device__ __forceinline__ float bf_lo(unsigned u) { return __builtin_bit_cast(float, u << 16); }
__device__ __forceinline__ float bf_hi(unsigned u) { return __builtin_bit_cast(float, u & 0xffff0000u); }
__device__ __forceinline__ void unpack8(const u32x4 u, float (&f)[8]) {
    f[0] = bf_lo(u.x); f[1] = bf_hi(u.x); f[2] = bf_lo(u.y); f[3] = bf_hi(u.y); f[4] = bf_lo(u.z); f[5] = bf_hi(u.z); f[6] = bf_lo(u.w); f[7] = bf_hi(u.w);
}
__device__ __forceinline__ u32x4 pack8m(const float (&f)[8]) { u32x4 u; u.x = pk2m(f[0], f[1]); u.y = pk2m(f[2], f[3]); u.z = pk2m(f[4], f[5]); u.w = pk2m(f[6], f[7]); return u; }
__device__ __forceinline__ u32x4 pack8(const float (&f)[8]) { u32x4 u; u.x = pk2(f[0], f[1]); u.y = pk2(f[2], f[3]); u.z = pk2(f[4], f[5]); u.w = pk2(f[6], f[7]); return u; }
__device__ __forceinline__ float wave_sum(float v) {
#pragma unroll
    for (int o = 1; o < 64; o <<= 1) v += __shfl_xor(v, o);
    return v;
}
__device__ __forceinline__ float wave_max(float v) {
#pragma unroll
    for (int o = 1; o < 64; o <<= 1) v = fmaxf(v, __shfl_xor(v, o));
    return v;
}
__device__ __forceinline__ float sigmoidf_(float z) { return __builtin_amdgcn_rcpf(1.f + __expf(-z)); }
__device__ __forceinline__ float gelu_tanh(float x) { const float u = 0.7978845608028654f * (x + 0.044715f * x * x * x); return x * __builtin_amdgcn_rcpf(1.f + __expf(-2.f * u)); }
__device__ __forceinline__ float silu_(float x) { return x * __builtin_amdgcn_rcpf(1.f + __expf(-x)); }

namespace pg8 {
#define PG8_LAS __attribute__((address_space(3)))
typedef unsigned short bf16_t;
typedef short bf16x8 __attribute__((ext_vector_type(8)));
typedef float f32x4 __attribute__((ext_vector_type(4)));
constexpr int BM = 256, BK = 64, HALF = 128, HTB = HALF * BK * 2, STAGE_BYTES = 8 * HTB, NXCD = 8, WGM = 8;

__host__ __device__ __forceinline__ int lds_byte(int r, int c) { const int st = (r >> 4) * 2 + (c >> 5), rr = r & 15, cc = c & 31, ob = rr * 64 + cc * 2; return st * 1024 + (ob ^ (((ob >> 9) & 1) << 5)); }
__host__ __device__ __forceinline__ void stage_rc(int b, int& R, int& C) { const int st = b / 1024, sb = b % 1024, swz = sb ^ (((sb >> 9) & 1) << 5); R = (st >> 1) * 16 + swz / 64; C = (st & 1) * 32 + (swz % 64) / 2; }
__host__ __device__ __forceinline__ int perm32(int rho) { const int n = rho >> 4, i = rho & 15; return 8 * (i >> 2) + 4 * n + (i & 3); }

struct Unit { int pm, pn; };
struct Gemm { const bf16_t* A; const bf16_t* Bt; int M, N, K, lda, ldb; };

struct StaticOrder {
    int nM, nN, nwg, G, c;
    __host__ __device__ void init(int M, int N, int G_, int c_) { nM = M / BM; nN = N / BM; nwg = nM * nN; G = G_; c = c_; }
    __host__ __device__ bool next(int i, Unit& u) const {
        const long L = (long)i * G + c; if (L >= nwg) return false;
        int wgid = (int)L; { const int q = nwg / NXCD, r = nwg % NXCD, xcd = wgid % NXCD, off = wgid / NXCD; wgid = (xcd < r ? xcd * (q + 1) : r * (q + 1) + (xcd - r) * q) + off; }
        const int nig = WGM * nN, gid = wgid / nig, fm = gid * WGM, gsz = (nM - fm) < WGM ? (nM - fm) : WGM;
        u.pm = fm + ((wgid % nig) % gsz); u.pn = (wgid % nig) / gsz; return true;
    }
};

template <class Epi, class Sched, bool ALIGN_EPI = false, bool SP2 = false>
__device__ __forceinline__ void gemm_phase(PG8_LAS unsigned char* lds, const Gemm g, const Sched& S, const Epi& E) {
    const int tid = tid_fresh(), wid = __builtin_amdgcn_readfirstlane(tid >> 6), lane = tid & 63, wr = wid >> 2, wc = wid & 3, fr = lane & 15, fq = lane >> 4;
    const int K = g.K, nt = K / BK;
    unsigned voffA[2], voffB[2];
#pragma unroll
    for (int i = 0; i < 2; ++i) { int R, C; stage_rc(tid * 16 + i * 8192, R, C); const int Rb = Epi::PERM ? ((R & ~31) + perm32(R & 31)) : R;
        voffA[i] = (unsigned)(R * g.lda + C) * 2u; voffB[i] = (unsigned)(Rb * g.ldb + C) * 2u; }
    const size_t kstep = (size_t)(BK * 2);
    const size_t hstepA = (size_t)HALF * g.lda * 2, hstepB = (size_t)HALF * g.ldb * 2;
    const size_t tstepA = 2 * hstepA, tstepB = 2 * hstepB;
    const unsigned ldsw = (unsigned)wid * 1024u;
    const int aoff = lds_byte(wr * 64 + fr, fq * 8), boff = lds_byte(wc * 32 + fr, fq * 8);
#define PG8_SA(b, h) (((b) * 2 + (h)) * HTB)
#define PG8_SB(b, h) ((4 + (b) * 2 + (h)) * HTB)
#define PG8_STAGE(bufoff, gbase, voff) do { _Pragma("unroll") for (int _i = 0; _i < 2; ++_i) \
        __builtin_amdgcn_global_load_lds((const unsigned*)((const char*)(gbase) + (voff)[_i]), (PG8_LAS unsigned*)(lds + (bufoff) + ldsw + _i * 8192), 16, 0, 0); } while (0)
#define PG8_LDA(dst, b, h) do { _Pragma("unroll") for (int m = 0; m < 4; ++m) _Pragma("unroll") for (int k = 0; k < 2; ++k) dst[m][k] = *(const PG8_LAS bf16x8*)(lds + PG8_SA(b, h) + aoff + m * 2048 + k * 1024); } while (0)
#define PG8_LDB(dst, b, h) do { _Pragma("unroll") for (int n = 0; n < 2; ++n) _Pragma("unroll") for (int k = 0; k < 2; ++k) dst[n][k] = *(const PG8_LAS bf16x8*)(lds + PG8_SB(b, h) + boff + n * 2048 + k * 1024); } while (0)
#define PG8_MMA(ai, bj, At, Bt) do { __builtin_amdgcn_s_setprio(1); _Pragma("unroll") for (int m = 0; m < 4; ++m) _Pragma("unroll") for (int n = 0; n < 2; ++n) _Pragma("unroll") for (int k = 0; k < 2; ++k) \
        acc[ai][bj][m][n] = __builtin_amdgcn_mfma_f32_16x16x32_bf16(Bt[n][k], At[m][k], acc[ai][bj][m][n], 0, 0, 0); __builtin_amdgcn_s_setprio(0); } while (0)
#define PG8_WAIT_V(n) asm volatile("s_waitcnt vmcnt(" #n ")" ::: "memory")
#define PG8_WAIT_L(n) asm volatile("s_waitcnt lgkmcnt(" #n ")" ::: "memory")
#define PG8_BAR __builtin_amdgcn_s_barrier()
#define PG8_SCHED __builtin_amdgcn_sched_barrier(0)
    Unit cur, nxt; int ui = 0;
    if (!S.next(0, cur)) return;
    f32x4 acc[2][2][4][2];
#pragma unroll
    for (int a = 0; a < 2; ++a)
#pragma unroll
        for (int b = 0; b < 2; ++b)
#pragma unroll
            for (int m = 0; m < 4; ++m)
#pragma unroll
                for (int n = 0; n < 2; ++n) acc[a][b][m][n] = (f32x4){0.f, 0.f, 0.f, 0.f};
    bf16x8 At[4][2], B0[2][2], B1[2][2];
    const char* cA = (const char*)g.A + (size_t)cur.pm * tstepA; const char* cB = (const char*)g.Bt + (size_t)cur.pn * tstepB;
    if constexpr (SP2) {
        PG8_STAGE(PG8_SB(0, 0), cB, voffB); PG8_STAGE(PG8_SB(0, 1), cB + hstepB, voffB); PG8_STAGE(PG8_SA(0, 0), cA, voffA); PG8_STAGE(PG8_SA(0, 1), cA + hstepA, voffA);
        if (wr == 1) PG8_BAR;
        PG8_WAIT_V(2); PG8_BAR;
        PG8_STAGE(PG8_SB(1, 0), cB + kstep, voffB); PG8_STAGE(PG8_SA(1, 0), cA + kstep, voffA); PG8_STAGE(PG8_SB(1, 1), cB + hstepB + kstep, voffB);
        PG8_WAIT_V(6); PG8_BAR;
    } else {
        PG8_STAGE(PG8_SB(0, 0), cB, voffB); PG8_STAGE(PG8_SA(0, 0), cA, voffA); PG8_STAGE(PG8_SB(0, 1), cB + hstepB, voffB); PG8_STAGE(PG8_SA(0, 1), cA + hstepA, voffA);
        if (wr == 1) PG8_BAR;
        PG8_WAIT_V(4); PG8_BAR;
        PG8_STAGE(PG8_SB(1, 0), cB + kstep, voffB); PG8_STAGE(PG8_SA(1, 0), cA + kstep, voffA); PG8_STAGE(PG8_SB(1, 1), cB + hstepB + kstep, voffB);
        PG8_WAIT_V(6); PG8_BAR;
    }
    for (;;) {
        const bool has_next = S.next(ui + 1, nxt);
        const char* nA = has_next ? (const char*)g.A + (size_t)nxt.pm * tstepA : cA; const char* nB = has_next ? (const char*)g.Bt + (size_t)nxt.pn * tstepB : cB;
        for (int t = 0; t < nt; t += 2) {
            if constexpr (Epi::MID) { if (t == (nt >> 1)) E.mid(acc, cur); }
            const bool last = (t == nt - 2);
            const char* a1 = cA + (size_t)(t + 1) * kstep;
            const char* a2 = last ? nA : cA + (size_t)(t + 2) * kstep; const char* b2 = last ? nB : cB + (size_t)(t + 2) * kstep;
            const char* a3 = a2 + kstep; const char* b3 = b2 + kstep;
            if constexpr (SP2) {
            PG8_LDB(B0, 0, 0); PG8_LDB(B1, 0, 1); PG8_SCHED; PG8_LDA(At, 0, 0); PG8_STAGE(PG8_SA(1, 1), a1 + hstepA, voffA);
            PG8_WAIT_V(8); PG8_WAIT_L(0); PG8_BAR; PG8_MMA(0, 0, At, B0); PG8_MMA(0, 1, At, B1); PG8_BAR; PG8_SCHED;
            PG8_LDA(At, 0, 1); PG8_STAGE(PG8_SB(0, 0), b2, voffB); PG8_STAGE(PG8_SB(0, 1), b2 + hstepB, voffB); PG8_STAGE(PG8_SA(0, 0), a2, voffA);
            PG8_WAIT_V(8); PG8_WAIT_L(0); PG8_BAR; PG8_MMA(1, 0, At, B0); PG8_MMA(1, 1, At, B1); PG8_BAR; PG8_SCHED;
            PG8_LDB(B0, 1, 0); PG8_LDB(B1, 1, 1); PG8_SCHED; PG8_LDA(At, 1, 0); PG8_STAGE(PG8_SA(0, 1), a2 + hstepA, voffA);
            PG8_WAIT_V(8); PG8_WAIT_L(0); PG8_BAR; PG8_MMA(0, 0, At, B0); PG8_MMA(0, 1, At, B1); PG8_BAR; PG8_SCHED;
            PG8_LDA(At, 1, 1); PG8_STAGE(PG8_SB(1, 0), b3, voffB); PG8_STAGE(PG8_SB(1, 1), b3 + hstepB, voffB); PG8_STAGE(PG8_SA(1, 0), a3, voffA);
            PG8_WAIT_V(8); PG8_WAIT_L(0); PG8_BAR; PG8_MMA(1, 0, At, B0); PG8_MMA(1, 1, At, B1); PG8_BAR; PG8_SCHED;
            } else {
            PG8_LDB(B0, 0, 0); PG8_SCHED; PG8_LDA(At, 0, 0); PG8_STAGE(PG8_SA(1, 1), a1 + hstepA, voffA);
            PG8_WAIT_L(8); PG8_BAR; PG8_WAIT_L(0); PG8_MMA(0, 0, At, B0); PG8_BAR; PG8_SCHED;
            PG8_LDB(B1, 0, 1); PG8_STAGE(PG8_SB(0, 0), b2, voffB);
            PG8_BAR; PG8_WAIT_L(0); PG8_MMA(0, 1, At, B1); PG8_BAR;
            PG8_LDA(At, 0, 1); PG8_STAGE(PG8_SA(0, 0), a2, voffA);
            PG8_BAR; PG8_WAIT_L(0); PG8_MMA(1, 0, At, B0); PG8_BAR; PG8_SCHED;
            PG8_STAGE(PG8_SB(0, 1), b2 + hstepB, voffB);
            PG8_WAIT_V(6); PG8_BAR; PG8_MMA(1, 1, At, B1); PG8_BAR;
            PG8_LDB(B0, 1, 0); PG8_SCHED; PG8_LDA(At, 1, 0); PG8_STAGE(PG8_SA(0, 1), a2 + hstepA, voffA);
            PG8_WAIT_L(8); PG8_BAR; PG8_WAIT_L(0); PG8_MMA(0, 0, At, B0); PG8_BAR; PG8_SCHED;
            PG8_LDB(B1, 1, 1); PG8_STAGE(PG8_SB(1, 0), b3, voffB);
            PG8_BAR; PG8_WAIT_L(0); PG8_MMA(0, 1, At, B1); PG8_BAR;
            PG8_LDA(At, 1, 1); PG8_STAGE(PG8_SA(1, 0), a3, voffA);
            PG8_BAR; PG8_WAIT_L(0); PG8_MMA(1, 0, At, B0); PG8_BAR; PG8_SCHED;
            PG8_STAGE(PG8_SB(1, 1), b3 + hstepB, voffB);
            PG8_WAIT_V(6); PG8_BAR; PG8_MMA(1, 1, At, B1); PG8_BAR;
            }
        }
        if constexpr (ALIGN_EPI) { if (wr == 0) PG8_BAR; }
        E(acc, cur, wr, wc, fr, fq);
        if (!has_next) break;
#pragma unroll
        for (int a = 0; a < 2; ++a)
#pragma unroll
            for (int b = 0; b < 2; ++b)
#pragma unroll
                for (int m = 0; m < 4; ++m)
#pragma unroll
                    for (int n = 0; n < 2; ++n) acc[a][b][m][n] = (f32x4){0.f, 0.f, 0.f, 0.f};
        cur = nxt; cA = nA; cB = nB; ++ui;
        if constexpr (ALIGN_EPI) { if (wr == 1) PG8_BAR; }
    }
    PG8_WAIT_V(0);
    if constexpr (!ALIGN_EPI) { if (wr == 0) PG8_BAR; }
    PG8_BAR;
#undef PG8_SA
#undef PG8_SB
#undef PG8_STAGE
#undef PG8_LDA
#undef PG8_LDB
#undef PG8_MMA
#undef PG8_WAIT_V
#undef PG8_WAIT_L
#undef PG8_BAR
#undef PG8_SCHED
}
}

template <class F> struct EpiAd {
    static constexpr bool PERM = true, AFTER_DRAIN = false, MID = false;
    F f;
    __device__ __forceinline__ void operator()(const pg8::f32x4 (&acc)[2][2][4][2], const pg8::Unit& u, int wr, int wc, int fr, int fq) const {
        const int row0 = u.pm * 256 + wr * 64 + fr, col0 = u.pn * 256 + wc * 32 + 8 * fq;
#pragma unroll
        for (int ai = 0; ai < 2; ++ai)
#pragma unroll
            for (int m = 0; m < 4; ++m)
            {
                float q = 0.f;
#pragma unroll
                for (int bj = 0; bj < 2; ++bj) {
                    float v[8];
#pragma unroll
                    for (int e = 0; e < 4; ++e) { v[e] = acc[ai][bj][m][0][e]; v[4 + e] = acc[ai][bj][m][1][e]; }
                    q += f.apply(row0 + ai * 128 + m * 16, col0 + bj * 128, v);
                }
                if constexpr (F::ROWSUM) {
                    q += __shfl_xor(q, 16); q += __shfl_xor(q, 32);
                    if (fq == 0) __hip_atomic_fetch_add(f.ss + row0 + ai * 128 + m * 16, q, __ATOMIC_RELAXED, __HIP_MEMORY_SCOPE_AGENT);
                }
            }
    }
};

struct EpiMerge {
    static constexpr bool PERM = true, AFTER_DRAIN = false, MID = true;
    const bf16* proj; bf16* merged;
    __device__ __forceinline__ void mid(pg8::f32x4 (&acc)[2][2][4][2], const pg8::Unit& u) const {
        const int tid = tid_fresh(), wid = __builtin_amdgcn_readfirstlane(tid >> 6), lane = tid & 63, wr = wid >> 2, wc = wid & 3, fr = lane & 15, fq = lane >> 4;
        const int row0 = u.pm * 256 + wr * 64 + fr, col0 = u.pn * 256 + wc * 32 + 8 * fq;
#pragma unroll
        for (int ai = 0; ai < 2; ++ai) {
            u32x4 ga[4][2], gb[4][2];
#pragma unroll
            for (int m = 0; m < 4; ++m)
#pragma unroll
                for (int bj = 0; bj < 2; ++bj) {
                    const bf16* gp = proj + (size_t)(row0 + ai * 128 + m * 16) * N1 + C_GATE + col0 + bj * 128;
                    ga[m][bj] = *(const u32x4*)gp; gb[m][bj] = *(const u32x4*)(gp + DM);
                }
#pragma unroll
            for (int m = 0; m < 4; ++m)
#pragma unroll
                for (int bj = 0; bj < 2; ++bj) {
                    float a[8], b[8]; unpack8(ga[m][bj], a); unpack8(gb[m][bj], b);
#pragma unroll
                    for (int e = 0; e < 4; ++e) {
                        acc[ai][bj][m][0][e] *= b[e] * __builtin_amdgcn_rcpf(fmaxf(a[e], 1e-30f));
                        acc[ai][bj][m][1][e] *= b[4 + e] * __builtin_amdgcn_rcpf(fmaxf(a[4 + e], 1e-30f));
                    }
                }
            __builtin_amdgcn_sched_barrier(0);
        }
    }
    __device__ __forceinline__ void operator()(const pg8::f32x4 (&acc)[2][2][4][2], const pg8::Unit& u, int, int, int, int) const {
        const int tid = tid_fresh(), wid = __builtin_amdgcn_readfirstlane(tid >> 6), lane = tid & 63, wr = wid >> 2, wc = wid & 3, fr = lane & 15, fq = lane >> 4;
        const int row0 = u.pm * 256 + wr * 64 + fr, col0 = u.pn * 256 + wc * 32 + 8 * fq;
#pragma unroll
        for (int ai = 0; ai < 2; ++ai)
#pragma unroll
            for (int m = 0; m < 4; ++m)
#pragma unroll
                for (int bj = 0; bj < 2; ++bj) {
                    const int row = row0 + ai * 128 + m * 16, col = col0 + bj * 128;
                    float ga[8], v[8]; unpack8(*(const u32x4*)(proj + (size_t)row * N1 + C_GATE + col), ga);
#pragma unroll
                    for (int e = 0; e < 4; ++e) { v[e] = acc[ai][bj][m][0][e] * ga[e]; v[4 + e] = acc[ai][bj][m][1][e] * ga[4 + e]; }
                    *(u32x4*)(merged + (size_t)row * DM + col) = pack8(v);
                }
    }
};

template <class F, bool ALIGN = true>
__device__ __forceinline__ void big_gemm(LAS unsigned char* lds, const bf16* A, int lda, const bf16* Bt, int ldb, int N, int K, const F& f) {
    pg8::Gemm g{A, Bt, MP, N, K, lda, ldb}; pg8::StaticOrder S; S.init(MP, N, (int)gridDim.x, (int)blockIdx.x);
    EpiAd<F> E{f};
    pg8::gemm_phase<EpiAd<F>, pg8::StaticOrder, ALIGN, true>(lds, g, S, E);
}

template <class F>
__device__ __forceinline__ void small_gemm(LAS unsigned char* lds, const bf16* A  , int lda, const bf16* Bt, int ldb, int N, int K, const F& f) {
    const int tid = tid_fresh(), wave = tid >> 6, lane = tid & 63, fr = lane & 15, fq = lane >> 4;
    LAS float* red = (LAS float*)lds;
    const int ntask = N / 16, kw = K / 8;
    for (int task = (int)(gridDim.x - 1 - blockIdx.x); task < ntask; task += gridDim.x) {
        const int n0 = task * 16;
        f32x4 c0 = {0.f, 0.f, 0.f, 0.f}, c1 = {0.f, 0.f, 0.f, 0.f};
        const bf16* a0 = A + (size_t)fr * lda + wave * kw + fq * 8;
        const bf16* a1 = a0 + (size_t)16 * lda;
        const bf16* bp = Bt + (size_t)(n0 + fr) * ldb + wave * kw + fq * 8;
#pragma unroll 8
        for (int k = 0; k < kw; k += 32) {
            const bf16x8 av0 = *(const bf16x8*)(a0 + k), av1 = *(const bf16x8*)(a1 + k), bv = *(const bf16x8*)(bp + k);
            c0 = __builtin_amdgcn_mfma_f32_16x16x32_bf16(av0, bv, c0, 0, 0, 0);
            c1 = __builtin_amdgcn_mfma_f32_16x16x32_bf16(av1, bv, c1, 0, 0, 0);
        }
#pragma unroll
        for (int r = 0; r < 4; ++r) { red[(wave * 32 + fq * 4 + r) * 16 + fr] = c0[r]; red[(wave * 32 + 16 + fq * 4 + r) * 16 + fr] = c1[r]; }
        __syncthreads();
        if (tid < 64) {
            const int row = tid >> 1, c8 = (tid & 1) * 8;
            float v[8];
#pragma unroll
            for (int e = 0; e < 8; ++e) v[e] = 0.f;
#pragma unroll
            for (int w = 0; w < 8; ++w)
#pragma unroll
                for (int e = 0; e < 8; ++e) v[e] += red[(w * 32 + row) * 16 + c8 + e];
            const float q = f.apply(MP + row, n0 + c8, v);
            if constexpr (F::ROWSUM) __hip_atomic_fetch_add(f.ss + MP + row, q, __ATOMIC_RELAXED, __HIP_MEMORY_SCOPE_AGENT);
        }
        __syncthreads();
    }
}

template <class F>
__device__ __forceinline__ void small_gemm_dual(LAS unsigned char* lds, const bf16* A, int lda, const bf16* Bt, int ldb, int N, const F& f) {
    const int tid = tid_fresh(), wave = tid >> 6, lane = tid & 63, fr = lane & 15, fq = lane >> 4;
    LAS float* red = (LAS float*)lds;
    const int ntask = N / 16, kw = 256;
    for (int task = (int)(gridDim.x - 1 - blockIdx.x); task < ntask; task += gridDim.x) {
        const int n0 = task * 16;
        f32x4 c0 = {0.f, 0.f, 0.f, 0.f}, c1 = {0.f, 0.f, 0.f, 0.f};
        const bf16* a0 = A + (size_t)fr * lda + wave * kw + fq * 8;
        const bf16* a1 = a0 + (size_t)16 * lda;
        const bf16* bp = Bt + (size_t)(n0 + fr) * ldb + wave * kw + fq * 8;
#pragma unroll
        for (int k = 0; k < kw; k += 32) {
            const bf16x8 av0 = *(const bf16x8*)(a0 + k), av1 = *(const bf16x8*)(a1 + k), bv = *(const bf16x8*)(bp + k);
            c0 = __builtin_amdgcn_mfma_f32_16x16x32_bf16(av0, bv, c0, 0, 0, 0);
            c1 = __builtin_amdgcn_mfma_f32_16x16x32_bf16(av1, bv, c1, 0, 0, 0);
        }
#pragma unroll
        for (int r = 0; r < 4; ++r) { red[(wave * 32 + fq * 4 + r) * 16 + fr] = c0[r]; red[(wave * 32 + 16 + fq * 4 + r) * 16 + fr] = c1[r]; }
        __syncthreads();
        if (tid < 64) {
            const int row = tid >> 1, c8 = (tid & 1) * 8;
            float va[8], vb[8];
#pragma unroll
            for (int e = 0; e < 8; ++e) { va[e] = 0.f; vb[e] = 0.f; }
#pragma unroll
            for (int w = 0; w < 4; ++w)
#pragma unroll
                for (int e = 0; e < 8; ++e) { va[e] += red[(w * 32 + row) * 16 + c8 + e]; vb[e] += red[((w + 4) * 32 + row) * 16 + c8 + e]; }
            f.apply2(MP + row, n0 + c8, va, vb);
        }
        __syncthreads();
    }
}

__device__ __forceinline__ void st8f(float* o, const float (&v)[8]) { *(f32x4*)o = (f32x4){v[0], v[1], v[2], v[3]}; *(f32x4*)(o + 4) = (f32x4){v[4], v[5], v[6], v[7]}; }
__device__ __forceinline__ void ld8f(const float* o, float (&v)[8]) { const f32x4 a = *(const f32x4*)o, b = *(const f32x4*)(o + 4); v[0] = a.x; v[1] = a.y; v[2] = a.z; v[3] = a.w; v[4] = b.x; v[5] = b.y; v[6] = b.z; v[7] = b.w; }

struct E1 {
    static constexpr bool ROWSUM = false;
    bf16* proj; const float* b_gate; float* out;
    __device__ __forceinline__ float apply(int row, int col, float (&v)[8]) const {
        if (col >= C_GATE) {
            float b[8]; ld8f(b_gate + (col - C_GATE), b);
#pragma unroll
            for (int e = 0; e < 8; ++e) v[e] = sigmoidf_(v[e] + b[e]);
        } else if (col >= C_GU) {
#pragma unroll
            for (int e = 0; e < 8; ++e) v[e] = gelu_tanh(v[e]);
        } else if (col >= C_V) {
            if (row < MP) { const int t = row & (SEQ - 1); if (t >= SEQ - 128) st8f(out + OFF_VP + ((size_t)((row >> 11) * 128 + (t - (SEQ - 128)))) * 256 + (col - C_V), v); }
            else st8f(out + OFF_VS + ((size_t)((row - MP) * 128 + 127)) * 256 + (col - C_V), v);
        }
        *(u32x4*)(proj + (size_t)row * N1 + col) = pack8(v);
        return 0.f;
    }
};
struct E2s {
    const bf16* proj; bf16* merged;
    __device__ __forceinline__ void apply2(int row, int col, float (&va)[8], float (&vb)[8]) const {
        float ga[8], gb[8]; unpack8(*(const u32x4*)(proj + (size_t)row * N1 + C_GATE + col), ga); unpack8(*(const u32x4*)(proj + (size_t)row * N1 + C_GATE + DM + col), gb);
#pragma unroll
        for (int e = 0; e < 8; ++e) va[e] = gb[e] * va[e] + ga[e] * vb[e];
        *(u32x4*)(merged + (size_t)row * DM + col) = pack8(va);
    }
};
struct E3 {
    static constexpr bool ROWSUM = true;
    const float *xp, *xs; bf16* res; const float* nw; bf16* xn; float* ss;
    __device__ __forceinline__ float apply(int row, int col, float (&v)[8]) const {
        const float* xr = row < MP ? xp + (size_t)row * DM : xs + (size_t)(row - MP) * DM;
        float x[8]; ld8f(xr + col, x);
        float q = 0.f;
#pragma unroll
        for (int e = 0; e < 8; ++e) { v[e] += x[e]; q += v[e] * v[e]; }
        *(u32x4*)(res + (size_t)row * DM + col) = pack8(v);
        return q;
    }
};
struct E4s {
    static constexpr bool ROWSUM = false;
    float* hs; float* out; const float* ss;
    __device__ __forceinline__ float apply(int row, int col, float (&v)[8]) const {
        const float rs = rsqrtf(ss[row] * (1.f / DM) + EPS);
#pragma unroll
        for (int e = 0; e < 8; ++e) v[e] *= rs;
        const int ch = (col >> 8) * 128 + (col & 127) + ((col & 128) ? DFF : 0);
        st8f(out + OFF_CS + ((size_t)((row - MP) * 2 + 1)) * NUP + ch, v);
        st8f(hs + (size_t)(row - MP) * NUP + col, v);
        return 0.f;
    }
};
template <int CTRL> __device__ __forceinline__ unsigned dppu(unsigned old, unsigned src) { return (unsigned)__builtin_amdgcn_update_dpp((int)old, (int)src, CTRL, 0xf, 0xf, false); }
template <int CTRL> __device__ __forceinline__ float dppf(float old, float src) {
    return __builtin_bit_cast(float, __builtin_amdgcn_update_dpp(__builtin_bit_cast(int, old), __builtin_bit_cast(int, src), CTRL, 0xf, 0xf, false));
}
struct EpiConv {
    static constexpr bool PERM = true, AFTER_DRAIN = false, MID = false;
    bf16* act; float* out; const float* ss; const float* cw; const float* cb; float* hb; LAS float* xb;
    __device__ __forceinline__ void operator()(const pg8::f32x4 (&acc)[2][2][4][2], const pg8::Unit& u, int, int, int, int) const {
        const int tid = tid_fresh(), wid = __builtin_amdgcn_readfirstlane(tid >> 6), lane = tid & 63, wr = wid >> 2, wc = wid & 3, fr = lane & 15, fq = lane >> 4;
        const int rowb = u.pm * 256 + wr * 64 + fr, cl = wc * 32 + 8 * fq, chg = u.pn * 128 + cl;
#define RS_(ai_, m_) __builtin_amdgcn_rsqf(ssl[(unsigned)(rowb + (ai_) * 128 + (m_) * 16)] * (1.f / DM) + EPS)
        const float* ssl = ss; asm volatile("" : "+s"(ssl));
        if (fr >= 14) {
#pragma unroll
            for (int ai = 0; ai < 2; ++ai) { LAS float* d = xb + ((ai * 2 + wr) * 2 + (fr - 14)) * 256 + cl; const float r3 = RS_(ai, 3);
#pragma unroll
                for (int bj = 0; bj < 2; ++bj) { *(LAS f32x4*)(d + bj * 128) = acc[ai][bj][3][0] * r3; *(LAS f32x4*)(d + bj * 128 + 4) = acc[ai][bj][3][1] * r3; } }
        }
        if (wr == 0 && fr < 2) { float* d = hb + (unsigned)((u.pm * 4 + fr) * NUP + u.pn * 256 + cl); const float r0 = RS_(0, 0);
#pragma unroll
            for (int bj = 0; bj < 2; ++bj) { *(f32x4*)(d + bj * 128) = acc[0][bj][0][0] * r0; *(f32x4*)(d + bj * 128 + 4) = acc[0][bj][0][1] * r0; } }
        if (wr == 1 && fr >= 14) { float* d = hb + (unsigned)((u.pm * 4 + 2 + fr - 14) * NUP + u.pn * 256 + cl); const float r3 = RS_(1, 3);
#pragma unroll
            for (int bj = 0; bj < 2; ++bj) { *(f32x4*)(d + bj * 128) = acc[1][bj][3][0] * r3; *(f32x4*)(d + bj * 128 + 4) = acc[1][bj][3][1] * r3; } }
        {
            LAS float* wl = xb + (WL_OFF - 131072) / 4; LAS float* rsl = xb + (RSL_OFF - 131072) / 4;
            const int idx = tid * 2, k = idx >> 8, c = idx & 255;
            const int chn = (c < 128) ? u.pn * 128 + c : DFF + u.pn * 128 + (c - 128);
            const float* src = (k < 3) ? cw + (unsigned)(k * NUP + chn) : cb + (unsigned)chn;
            const f32x2_t wv = *(const f32x2_t*)src;
            *(LAS f32x2_t*)(wl + idx) = wv;
            if (tid < 256) rsl[tid] = __builtin_amdgcn_rsqf(ssl[(unsigned)(u.pm * 256 + tid)] * (1.f / DM) + EPS);
        }
        __builtin_amdgcn_sched_barrier(0);
        asm volatile("s_waitcnt lgkmcnt(0)" ::: "memory");
        __builtin_amdgcn_s_barrier();
        const LAS float* wl = xb + (WL_OFF - 131072) / 4; const LAS float* rsl = xb + (RSL_OFF - 131072) / 4 + wr * 64 + fr;
#pragma unroll
        for (int ai = 0; ai < 2; ++ai)
#pragma unroll
            for (int m = 0; m < 4; ++m) {
                const int row = rowb + ai * 128 + m * 16, t = row & (SEQ - 1);
                const float rsc = rsl[ai * 128 + m * 16], rsp = rsl[ai * 128 + (m > 0 ? m - 1 : 0) * 16];
                unsigned opk[4];
#pragma unroll
                for (int n = 0; n < 2; ++n) {
                    float o[4];
#pragma unroll
                    for (int bj = 0; bj < 2; ++bj) {
                        const int ch = chg + bj * DFF;
                        const f32x4 cur = acc[ai][bj][m][n] * rsc;
                        f32x4 xp = {0.f, 0.f, 0.f, 0.f};
                        if (m > 0) xp = acc[ai][bj][m > 0 ? m - 1 : 0][n] * rsp;
                        else if (!(ai == 0 && wr == 0) && fr >= 14)
                            xp = *(const LAS f32x4*)(xb + ((wr == 1 ? (ai * 2 + 0) : ((ai - 1) * 2 + 1)) * 2 + (fr - 14)) * 256 + bj * 128 + cl + 4 * n);
                        const unsigned c01 = pk2m(cur[0], cur[1]), c23 = pk2m(cur[2], cur[3]), x01 = pk2m(xp[0], xp[1]), x23 = pk2m(xp[2], xp[3]);
                        unsigned a01 = dppu<0x111>(dppu<0x121>(0u, x01), c01), a23 = dppu<0x111>(dppu<0x121>(0u, x23), c23);
                        unsigned b01 = dppu<0x112>(dppu<0x122>(0u, x01), c01), b23 = dppu<0x112>(dppu<0x122>(0u, x23), c23);
                        if (t < 1) { a01 = 0u; a23 = 0u; }
                        if (t < 2) { b01 = 0u; b23 = 0u; }
                        const float p1[4] = {bf_lo(a01), bf_hi(a01), bf_lo(a23), bf_hi(a23)}, p2[4] = {bf_lo(b01), bf_hi(b01), bf_lo(b23), bf_hi(b23)};
                        const LAS float* wp = wl + bj * 128 + cl + 4 * n;
                        const f32x4 w0 = *(const LAS f32x4*)wp, w1 = *(const LAS f32x4*)(wp + 256), w2 = *(const LAS f32x4*)(wp + 512), bb = *(const LAS f32x4*)(wp + 768);
                        if (t >= SEQ - 2) *(f32x4*)(out + OFF_CP + (unsigned)(((row >> 11) * 2 + (t - (SEQ - 2))) * NUP + ch + 4 * n)) = cur;
#pragma unroll
                        for (int e = 0; e < 4; ++e) {
                            const float hc = w0[e] * p2[e] + w1[e] * p1[e] + w2[e] * cur[e] + bb[e];
                            if (bj == 0) o[e] = silu_(hc); else o[e] *= hc;
                        }
                    }
                    opk[2 * n] = pk2(o[0], o[1]); opk[2 * n + 1] = pk2(o[2], o[3]);
                }
                *(u32x4*)(act + (unsigned)(row * DFF + chg)) = (u32x4){opk[0], opk[1], opk[2], opk[3]};
                __builtin_amdgcn_sched_barrier(0);
            }
#undef RS_
    }
};
struct E5 {
    static constexpr bool ROWSUM = true;
    const bf16* rin; bf16* rout; const float* nw; bf16* xn; float* ss;
    __device__ __forceinline__ float apply(int row, int col, float (&v)[8]) const {
        float x[8]; unpack8(*(const u32x4*)(rin + (size_t)row * DM + col), x);
        float q = 0.f;
#pragma unroll
        for (int e = 0; e < 8; ++e) { v[e] += x[e]; q += v[e] * v[e]; }
        *(u32x4*)(rout + (size_t)row * DM + col) = pack8(v);
        return q;
    }
};
struct E6a {
    static constexpr bool ROWSUM = false;
    bf16* pp;
    __device__ __forceinline__ float apply(int row, int col, float (&v)[8]) const { *(u32x4*)(pp + (size_t)row * DM + col) = pack8(v); return 0.f; }
};
struct E6b {
    static constexpr bool ROWSUM = false;
    const bf16* pp; const bf16* res; float* y; const float* ss;
    __device__ __forceinline__ float apply(int row, int col, float (&v)[8]) const {
        const float rs = rsqrtf(ss[row] * (1.f / DM) + EPS);
        float x[8], q[8]; unpack8(*(const u32x4*)(res + (size_t)row * DM + col), x); unpack8(*(const u32x4*)(pp + (size_t)row * DM + col), q);
#pragma unroll
        for (int e = 0; e < 8; ++e) v[e] = x[e] + sigmoidf_(v[e] * rs) * q[e];
        st8f(y + (size_t)row * DM + col, v);
        return 0.f;
    }
};

struct TItem { const float* src; bf16* dst; const float* ksc; int N, ldk; };
constexpr int I_IN = 32 * 112, I_GATE = 32 * 128, I_BA = 16 * 64, I_BG = 16 * 64, I_OUT = 32 * 64, I_UP = 32 * 352, I_DOWN = 88 * 64, I_PG = 32 * 64, I_PP = 4 * 64;
constexpr int NITEMS = I_IN + I_GATE + I_BA + I_BG + I_OUT + I_UP + I_DOWN + I_PG + I_PP, I_EARLY = I_IN + I_GATE + I_PP, I_MID = I_EARLY + I_BA + I_BG + I_OUT;
__device__ __forceinline__ TItem titem_mk(const float* W, int N, bf16* WT, int ldk, int item, bool upperm, const float* kscale = nullptr) {
    const int nblk = N / 32, kb = item / nblk, nb = item - kb * nblk, k0 = 64 * kb, n0 = 32 * nb;
    const int r0 = !upperm ? n0 : (n0 < DFF ? (n0 >> 7) * 256 + (n0 & 127) : ((n0 - DFF) >> 7) * 256 + 128 + ((n0 - DFF) & 127));
    TItem t; t.src = W + (size_t)k0 * N + n0; t.dst = WT + (size_t)r0 * ldk + k0; t.ksc = kscale ? kscale + k0 : nullptr; t.N = N; t.ldk = ldk; return t;
}
__device__ __forceinline__ TItem titem(KP p, int it) {
    unsigned char* ws = p->ws; int r = it;
    if (r < I_IN) return titem_mk(p->w_in, 3584, (bf16*)(ws + WS_W1), 2048, r, false); r -= I_IN;
    if (r < I_GATE) return titem_mk(p->w_gate, 4096, (bf16*)(ws + WS_W1) + (size_t)C_GATE * 2048, 2048, r, false); r -= I_GATE;
    if (r < I_PP) return titem_mk(p->w_ple_proj, 2048, (bf16*)(ws + WS_WPP), PLE, r, false); r -= I_PP;
    if (r < I_BA) return titem_mk(p->w_br_attn, 2048, (bf16*)(ws + WS_WBA), 2048, r, false); r -= I_BA;
    if (r < I_BG) return titem_mk(p->w_br_gm, 2048, (bf16*)(ws + WS_WBA) + 1024, 2048, r, false); r -= I_BG;
    if (r < I_OUT) return titem_mk(p->w_out, 2048, (bf16*)(ws + WS_WOUT), 2048, r, false); r -= I_OUT;
    if (r < I_UP) return titem_mk(p->w_up, NUP, (bf16*)(ws + WS_WUP), 2048, r, true, p->ffn_norm_w); r -= I_UP;
    if (r < I_DOWN) return titem_mk(p->w_down, 2048, (bf16*)(ws + WS_WDOWN), DFF, r, false); r -= I_DOWN;
    return titem_mk(p->w_ple_gate, 2048, (bf16*)(ws + WS_WPG), 2048, r, false, p->ple_norm_w);
}
__device__ __forceinline__ void tload(const TItem& s, f32x4 (&t)[8], int lane) {
#pragma unroll
    for (int j = 0; j < 8; ++j) t[j] = __builtin_nontemporal_load((const f32x4*)(s.src + (size_t)((lane >> 3) + 8 * j) * s.N + (lane & 7) * 4));
    if (s.ksc) {
#pragma unroll
        for (int j = 0; j < 8; ++j) t[j] = t[j] * s.ksc[(lane >> 3) + 8 * j];
    }
}
__device__ __forceinline__ void tstore(const TItem& s, const f32x4 (&t)[8], LAS float* scr, int lane) {
#pragma unroll
    for (int j = 0; j < 8; ++j) { LAS float* d = scr + ((lane >> 3) + 8 * j) * 33 + (lane & 7) * 4; d[0] = t[j].x; d[1] = t[j].y; d[2] = t[j].z; d[3] = t[j].w; }
    asm volatile("s_waitcnt lgkmcnt(0)" ::: "memory");
    const int c = lane & 7;
#pragma unroll
    for (int j = 0; j < 4; ++j) { const int n = (lane >> 3) + 8 * j; const LAS float* q = scr + (8 * c) * 33 + n;
        u32x4 o; o.x = pk2(q[0 * 33], q[1 * 33]); o.y = pk2(q[2 * 33], q[3 * 33]); o.z = pk2(q[4 * 33], q[5 * 33]); o.w = pk2(q[6 * 33], q[7 * 33]);
        *(u32x4*)(s.dst + (size_t)n * s.ldk + 8 * c) = o; }
    asm volatile("s_waitcnt lgkmcnt(0)" ::: "memory");
}
__device__ __forceinline__ void convert_items(LAS unsigned char* lds, KP p, int lo, int hi, int w, int NW, int wave, int lane) {
    LAS float* scr = (LAS float*)(lds + wave * 16384);
    int it = lo + w; if (it >= hi) return;
    TItem cur = titem(p, it); f32x4 t[8]; tload(cur, t, lane);
    for (;;) {
        const int nx = it + NW; const bool has = nx < hi;
        TItem nxt = cur; f32x4 tn[8];
#pragma unroll
        for (int j = 0; j < 8; ++j) tn[j] = t[j];
        if (has) { nxt = titem(p, nx); tload(nxt, tn, lane); }
        tstore(cur, t, scr, lane);
        if (!has) break;
        cur = nxt; it = nx;
#pragma unroll
        for (int j = 0; j < 8; ++j) t[j] = tn[j];
    }
}
__device__ __forceinline__ void rms_row(const float* xrow, const float* w, bf16* orow, int lane) {
    f32x4 v[8]; float s = 0.f;
#pragma unroll
    for (int j = 0; j < 8; ++j) { v[j] = __builtin_nontemporal_load((const f32x4*)(xrow + lane * 4 + 256 * j)); s += (v[j].x * v[j].x + v[j].y * v[j].y) + (v[j].z * v[j].z + v[j].w * v[j].w); }
    const float rs = rsqrtf(wave_sum(s) * (1.f / DM) + EPS);
#pragma unroll
    for (int j = 0; j < 8; ++j) { const f32x4 ww = *(const f32x4*)(w + lane * 4 + 256 * j);
        u32x2 o; o.x = pk2(v[j].x * rs * ww.x, v[j].y * rs * ww.y); o.y = pk2(v[j].z * rs * ww.z, v[j].w * rs * ww.w);
        *(u32x2*)(orow + lane * 4 + 256 * j) = o; }
}
__device__ __forceinline__ void rms_phase(const float* src  , const float* w, bf16* dst) {
    const int tid = tid_fresh(), lane = tid & 63, gw = blockIdx.x * 8 + (tid >> 6), NGW = gridDim.x * 8;
    for (int m = gw; m < MALL; m += NGW) rms_row(src + (size_t)m * DM, w, dst + (size_t)m * DM, lane);
}

__device__ __forceinline__ void p0_phase(LAS unsigned char* lds, KP p) {
    const int tid = tid_fresh(), lane = tid & 63, wave = tid >> 6, gw = blockIdx.x * 8 + wave, NGW = gridDim.x * 8;
    unsigned char* ws = p->ws;
    convert_items(lds, p, 0, I_EARLY, blockIdx.x * 8 + __builtin_amdgcn_readfirstlane(wave), NGW, wave, lane);
    for (int i = blockIdx.x * 512 + tid; i < 32768; i += gridDim.x * 512) ((float*)ws)[i] = 0.f;
    bf16* XN = (bf16*)(ws + WS_XN); bf16* PBF = (bf16*)(ws + WS_PBF);
    for (int m = gw; m < MALL; m += NGW) {
        const float* xr = m < MP ? p->x_prompt + (size_t)m * DM : p->x_sample + (size_t)(m - MP) * DM;
        rms_row(xr, p->attn_norm_w, XN + (size_t)m * DM, lane);
        const float* pr = m < MP ? p->p_prompt + (size_t)m * PLE : p->p_sample + (size_t)(m - MP) * PLE;
        const f32x4 pv = *(const f32x4*)(pr + lane * 4);
        u32x2 o; o.x = pk2(pv.x, pv.y); o.y = pk2(pv.z, pv.w);
        *(u32x2*)(PBF + (size_t)m * PLE + lane * 4) = o;
    }
}

__device__ __forceinline__ void attn_prompt_unit(LAS unsigned char* lds, KP p, const bf16* proj, bf16* mix, int unit) {
    const int tid = tid_fresh(), wave = tid >> 6, lane = tid & 63, fr = lane & 15, fq = lane >> 4;
    const int kh = unit & 3, c = (unit >> 2) & 15, b = unit >> 6;
    LAS bf16* Ks = (LAS bf16*)lds;
    LAS bf16* Vt = (LAS bf16*)(lds + 36864);
#pragma unroll
    for (int i = 0; i < 4; ++i) {
        const int id = tid + 512 * i, j = id >> 3, ch = id & 7;
        const int pos = 128 * (c - 1) + j;
        u32x4 kraw = {0u, 0u, 0u, 0u}, vraw = {0u, 0u, 0u, 0u};
        if (pos >= 0) { const bf16* rp = proj + (size_t)(b * SEQ + pos) * N1; kraw = *(const u32x4*)(rp + C_K + kh * 64 + ch * 8); vraw = *(const u32x4*)(rp + C_V + kh * 64 + ch * 8); }
        float kf[8]; unpack8(kraw, kf);
        float ss = 0.f;
#pragma unroll
        for (int e = 0; e < 8; ++e) ss += kf[e] * kf[e];
        ss += __shfl_xor(ss, 1); ss += __shfl_xor(ss, 2); ss += __shfl_xor(ss, 4);
        const float rs = rsqrtf(ss * (1.f / 64.f) + EPS);
        float kw[8]; ld8f(p->k_norm_w + ch * 8, kw);
#pragma unroll
        for (int e = 0; e < 8; ++e) kf[e] = kf[e] * rs * kw[e];
        if (pos >= SEQ - 128) st8f(p->out + OFF_KP + ((size_t)((b * 128 + pos - (SEQ - 128)) * 4 + kh)) * 64 + ch * 8, kf);
        *(LAS u32x4*)(Ks + j * 72 + ch * 8) = pack8(kf);
        const unsigned vw[4] = {vraw.x, vraw.y, vraw.z, vraw.w};
#pragma unroll
        for (int e = 0; e < 8; ++e) Vt[(ch * 8 + e) * 264 + j] = (bf16)((e & 1) ? (vw[e >> 1] >> 16) : (vw[e >> 1] & 0xffffu));
    }
    __syncthreads();
    const int h = kh * 4 + (wave >> 1);
    const float slope = exp2f(-0.5f * (float)(h + 1)), sink = p->sinks[h];
    float qw0[8], qw1[8]; ld8f(p->q_norm_w + fq * 8, qw0); ld8f(p->q_norm_w + 32 + fq * 8, qw1);
    u32x4 qn0, qn1;
    { const bf16* qp = proj + (size_t)(b * SEQ + c * 128 + (wave & 1) * 64 + fr) * N1 + h * 64 + fq * 8; qn0 = *(const u32x4*)qp; qn1 = *(const u32x4*)(qp + 32); }
    for (int it = 0; it < 4; ++it) {
        int oz = 0; asm volatile("" : "+v"(oz));
        const LAS bf16* Ksi = Ks + oz; const LAS bf16* Vti = Vt + oz;
        const int qi = (wave & 1) * 64 + it * 16 + fr;
        const size_t qrow = (size_t)(b * SEQ + c * 128 + qi);
        float q0[8], q1[8]; unpack8(qn0, q0); unpack8(qn1, q1);
        { const int itn = it < 3 ? it + 1 : 3;
          const bf16* qp = proj + (size_t)(b * SEQ + c * 128 + (wave & 1) * 64 + itn * 16 + fr) * N1 + h * 64 + fq * 8; qn0 = *(const u32x4*)qp; qn1 = *(const u32x4*)(qp + 32); }
        float ss = 0.f;
#pragma unroll
        for (int e = 0; e < 8; ++e) ss += q0[e] * q0[e] + q1[e] * q1[e];
        ss += __shfl_xor(ss, 16); ss += __shfl_xor(ss, 32);
        const float rs = rsqrtf(ss * (1.f / 64.f) + EPS) * 0.125f;
#pragma unroll
        for (int e = 0; e < 8; ++e) { q0[e] = q0[e] * rs * qw0[e]; q1[e] = q1[e] * rs * qw1[e]; }
        const bf16x8 qb0 = __builtin_bit_cast(bf16x8, pack8m(q0)), qb1 = __builtin_bit_cast(bf16x8, pack8m(q1));
        f32x4 S[16];
#pragma unroll
        for (int T = 0; T < 16; ++T) {
            S[T] = (f32x4){0.f, 0.f, 0.f, 0.f};
            const LAS bf16* kp = Ksi + (T * 16 + fr) * 72 + fq * 8;
            S[T] = __builtin_amdgcn_mfma_f32_16x16x32_bf16(*(const LAS bf16x8*)kp, qb0, S[T], 0, 0, 0);
            S[T] = __builtin_amdgcn_mfma_f32_16x16x32_bf16(*(const LAS bf16x8*)(kp + 32), qb1, S[T], 0, 0, 0);
        }
        float mx = sink;
#pragma unroll
        for (int T = 0; T < 16; ++T)
#pragma unroll
            for (int r = 0; r < 4; ++r) {
                const int j = T * 16 + fq * 4 + r, dist = 128 + qi - j;
                const bool valid = (dist >= 0) && (dist <= 128) && (c > 0 || j >= 128);
                const float s = valid ? S[T][r] - slope * (float)dist : -1e30f;
                S[T][r] = s; mx = fmaxf(mx, s);
            }
        mx = fmaxf(mx, __shfl_xor(mx, 16)); mx = fmaxf(mx, __shfl_xor(mx, 32));
        float sum = 0.f;
#pragma unroll
        for (int T = 0; T < 16; ++T)
#pragma unroll
            for (int r = 0; r < 4; ++r) { const float pv = __expf(S[T][r] - mx); S[T][r] = pv; sum += pv; }
        sum += __shfl_xor(sum, 16); sum += __shfl_xor(sum, 32);
        sum += __expf(sink - mx);
        f32x4 O[4];
#pragma unroll
        for (int dt = 0; dt < 4; ++dt) O[dt] = (f32x4){0.f, 0.f, 0.f, 0.f};
#pragma unroll
        for (int s = 0; s < 8; ++s) {
            u32x4 pw; pw.x = pk2m(S[2 * s][0], S[2 * s][1]); pw.y = pk2m(S[2 * s][2], S[2 * s][3]); pw.z = pk2m(S[2 * s + 1][0], S[2 * s + 1][1]); pw.w = pk2m(S[2 * s + 1][2], S[2 * s + 1][3]);
            const bf16x8 pb = __builtin_bit_cast(bf16x8, pw);
#pragma unroll
            for (int dt = 0; dt < 4; ++dt) {
                const LAS bf16* vp = Vti + (dt * 16 + fr) * 264 + s * 32 + fq * 4;
                const u32x2 lo = *(const LAS u32x2*)vp, hi = *(const LAS u32x2*)(vp + 16);
                u32x4 vv; vv.x = lo.x; vv.y = lo.y; vv.z = hi.x; vv.w = hi.y;
                O[dt] = __builtin_amdgcn_mfma_f32_16x16x32_bf16(__builtin_bit_cast(bf16x8, vv), pb, O[dt], 0, 0, 0);
            }
        }
        const float inv = 1.f / sum;
#pragma unroll
        for (int dt = 0; dt < 4; ++dt) { u32x2 o; o.x = pk2(O[dt][0] * inv, O[dt][1] * inv); o.y = pk2(O[dt][2] * inv, O[dt][3] * inv);
            *(u32x2*)(mix + qrow * DM + h * 64 + dt * 16 + fq * 4) = o; }
    }
    __syncthreads();
}

__device__ __forceinline__ void sgu_prompt_unit(LAS unsigned char* lds, KP p, const bf16* proj, bf16* mix, int unit) {
    const int tid = tid_fresh(), wave = tid >> 6, lane = tid & 63, fr = lane & 15, fq = lane >> 4;
    const int g = unit & 3, c = (unit >> 2) & 15, b = unit >> 6;
    LAS bf16* vnT = (LAS bf16*)lds;
    LAS bf16* Wl = (LAS bf16*)(lds + 69632);
#pragma unroll
    for (int i = 0; i < 8; ++i) {
        const int id = tid + 512 * i, t = id >> 5, s4 = (id & 31) * 4;
        const f32x4 w = *(const f32x4*)(p->sgu_w + (size_t)(g * 128 + t) * 128 + s4);
        u32x2 o; o.x = pk2(s4 <= t ? w.x : 0.f, s4 + 1 <= t ? w.y : 0.f); o.y = pk2(s4 + 2 <= t ? w.z : 0.f, s4 + 3 <= t ? w.w : 0.f);
        *(LAS u32x2*)(Wl + t * 136 + s4) = o;
    }
    float nw[16];
    { float a[8], bq[8]; ld8f(p->sgu_norm_w + lane * 16, a); ld8f(p->sgu_norm_w + lane * 16 + 8, bq);
#pragma unroll
      for (int e = 0; e < 8; ++e) { nw[e] = a[e]; nw[8 + e] = bq[e]; } }
    for (int r8 = 0; r8 < 16; r8 += 8) {
        const int s0 = wave * 16 + r8;
        float x[8][16];
#pragma unroll
        for (int q = 0; q < 8; ++q) {
            const bf16* gp = proj + (size_t)(b * SEQ + c * 128 + s0 + q) * N1 + C_GV + lane * 16;
            const u32x4 ua = *(const u32x4*)gp, ub = *(const u32x4*)(gp + 8);
            float a[8], bq[8]; unpack8(ua, a); unpack8(ub, bq);
#pragma unroll
            for (int e = 0; e < 8; ++e) { x[q][e] = a[e]; x[q][8 + e] = bq[e]; }
        }
        float mean[8], rstd[8];
#pragma unroll
        for (int q = 0; q < 8; ++q) { float sm = 0.f;
#pragma unroll
            for (int e = 0; e < 16; ++e) sm += x[q][e];
            mean[q] = wave_sum(sm) * (1.f / 1024.f); }
#pragma unroll
        for (int q = 0; q < 8; ++q) { float sq = 0.f;
#pragma unroll
            for (int e = 0; e < 16; ++e) { x[q][e] -= mean[q]; sq += x[q][e] * x[q][e]; }
            rstd[q] = rsqrtf(wave_sum(sq) * (1.f / 1024.f) + EPS); }
        if (fq == g) {
#pragma unroll
            for (int q = 0; q < 8; ++q) {
#pragma unroll
                for (int e = 0; e < 16; ++e) x[q][e] = x[q][e] * rstd[q] * nw[e];
                if (c == 15) { float* o = p->out + OFF_GP + ((size_t)(b * 128 + s0 + q)) * 1024 + lane * 16;
#pragma unroll
                    for (int e4 = 0; e4 < 4; ++e4) *(f32x4*)(o + 4 * e4) = (f32x4){x[q][4 * e4], x[q][4 * e4 + 1], x[q][4 * e4 + 2], x[q][4 * e4 + 3]}; }
            }
#pragma unroll
            for (int e = 0; e < 16; ++e) {
                u32x4 w; w.x = pk2(x[0][e], x[1][e]); w.y = pk2(x[2][e], x[3][e]); w.z = pk2(x[4][e], x[5][e]); w.w = pk2(x[6][e], x[7][e]);
                *(LAS u32x4*)(vnT + (fr * 16 + e) * 136 + s0) = w;
            }
        }
    }
    __syncthreads();
    f32x4 acc[8][2];
#pragma unroll
    for (int tt = 0; tt < 8; ++tt) { acc[tt][0] = (f32x4){0.f, 0.f, 0.f, 0.f}; acc[tt][1] = (f32x4){0.f, 0.f, 0.f, 0.f}; }
#pragma unroll
    for (int ks = 0; ks < 4; ++ks) {
        const bf16x8 a0 = *(const LAS bf16x8*)(vnT + (wave * 32 + fr) * 136 + ks * 32 + fq * 8);
        const bf16x8 a1 = *(const LAS bf16x8*)(vnT + (wave * 32 + 16 + fr) * 136 + ks * 32 + fq * 8);
#pragma unroll
        for (int tt = 2 * ks; tt < 8; ++tt) {
            const bf16x8 bw = *(const LAS bf16x8*)(Wl + (tt * 16 + fr) * 136 + ks * 32 + fq * 8);
            acc[tt][0] = __builtin_amdgcn_mfma_f32_16x16x32_bf16(a0, bw, acc[tt][0], 0, 0, 0);
            acc[tt][1] = __builtin_amdgcn_mfma_f32_16x16x32_bf16(a1, bw, acc[tt][1], 0, 0, 0);
        }
    }
#pragma unroll
    for (int tt = 0; tt < 8; ++tt) {
        const int t = tt * 16 + fr; const size_t row = (size_t)(b * SEQ + c * 128 + t);
        const float bias = p->sgu_b[g * 128 + t];
#pragma unroll
        for (int ct = 0; ct < 2; ++ct) {
            const int ch = g * 256 + wave * 32 + ct * 16 + fq * 4;
            const u32x2 gu = *(const u32x2*)(proj + row * N1 + C_GU + ch);
            u32x2 o; o.x = pk2((acc[tt][ct][0] + bias) * bf_lo(gu.x), (acc[tt][ct][1] + bias) * bf_hi(gu.x));
            o.y = pk2((acc[tt][ct][2] + bias) * bf_lo(gu.y), (acc[tt][ct][3] + bias) * bf_hi(gu.y));
            *(u32x2*)(mix + row * DM + 1024 + ch) = o;
        }
    }
    __syncthreads();
}

__device__ __forceinline__ void sample_attn_item(LAS float* wl  , KP p, const bf16* proj, bf16* mix, int item, int lane) {
    const int h = item & 15, b = item >> 4, kh = h >> 2;
    const bf16* rp = proj + (size_t)(MP + b) * N1;
    float q = bf_lo((unsigned)rp[h * 64 + lane]), kn = bf_lo((unsigned)rp[C_K + kh * 64 + lane]), vn = bf_lo((unsigned)rp[C_V + kh * 64 + lane]);
    q = q * rsqrtf(wave_sum(q * q) * (1.f / 64.f) + EPS) * p->q_norm_w[lane] * 0.125f;
    kn = kn * rsqrtf(wave_sum(kn * kn) * (1.f / 64.f) + EPS) * p->k_norm_w[lane];
    const float slope = exp2f(-0.5f * (float)(h + 1)), sink = p->sinks[h];
    wl[lane] = q;
    asm volatile("s_waitcnt lgkmcnt(0)" ::: "memory");
    const float* kb = p->st_k + ((size_t)b * 128 * 4 + kh) * 64;
    float s0 = 0.f, s1 = 0.f;
    { const float* k0 = kb + (size_t)lane * 256; const float* k1 = kb + (size_t)(lane + 64) * 256;
#pragma unroll
      for (int d = 0; d < 64; d += 4) { const f32x4 a = *(const f32x4*)(k0 + d), c4 = *(const f32x4*)(k1 + d);
          const float w0 = wl[d], w1 = wl[d + 1], w2 = wl[d + 2], w3 = wl[d + 3];
          s0 += a.x * w0 + a.y * w1 + a.z * w2 + a.w * w3; s1 += c4.x * w0 + c4.y * w1 + c4.z * w2 + c4.w * w3; } }
    const float* vb = p->st_v + ((size_t)b * 128 * 4 + kh) * 64 + lane;
    float vv[128];
#pragma unroll
    for (int j = 0; j < 128; ++j) vv[j] = vb[(size_t)j * 256];
    s0 -= slope * (float)(128 - lane); s1 -= slope * (float)(64 - lane);
    const float sn = wave_sum(q * kn);
    const float mx = fmaxf(fmaxf(wave_max(fmaxf(s0, s1)), sn), sink);
    const float p0 = __expf(s0 - mx), p1 = __expf(s1 - mx), pn = __expf(sn - mx);
    const float den = wave_sum(p0 + p1) + pn + __expf(sink - mx);
    wl[64 + lane] = p0; wl[128 + lane] = p1;
    asm volatile("s_waitcnt lgkmcnt(0)" ::: "memory");
    float o = pn * vn;
#pragma unroll
    for (int j = 0; j < 128; ++j) o += wl[64 + j] * vv[j];
    mix[(size_t)(MP + b) * DM + h * 64 + lane] = (bf16)(pk2(o / den, 0.f) & 0xffffu);
    if ((h & 3) == 0) p->out[OFF_KS + ((size_t)(b * 128 + 127) * 4 + kh) * 64 + lane] = kn;
    asm volatile("s_waitcnt lgkmcnt(0)" ::: "memory");
}
__device__ __forceinline__ void sample_sgu_item(KP p, const bf16* proj, bf16* mix, int b, int lane) {
    const bf16* rp = proj + (size_t)(MP + b) * N1;
    float x[16];
    { float a[8], bq[8]; unpack8(*(const u32x4*)(rp + C_GV + lane * 16), a); unpack8(*(const u32x4*)(rp + C_GV + lane * 16 + 8), bq);
#pragma unroll
      for (int e = 0; e < 8; ++e) { x[e] = a[e]; x[8 + e] = bq[e]; } }
    float sm = 0.f;
#pragma unroll
    for (int e = 0; e < 16; ++e) sm += x[e];
    const float mean = wave_sum(sm) * (1.f / 1024.f);
    float sq = 0.f;
#pragma unroll
    for (int e = 0; e < 16; ++e) { x[e] -= mean; sq += x[e] * x[e]; }
    const float rstd = rsqrtf(wave_sum(sq) * (1.f / 1024.f) + EPS);
    const int g = lane >> 4;
    const float w00 = p->sgu_w[(size_t)g * 128 * 128], b0 = p->sgu_b[g * 128];
    float gu[16];
    { float a[8], bq[8]; unpack8(*(const u32x4*)(rp + C_GU + lane * 16), a); unpack8(*(const u32x4*)(rp + C_GU + lane * 16 + 8), bq);
#pragma unroll
      for (int e = 0; e < 8; ++e) { gu[e] = a[e]; gu[8 + e] = bq[e]; } }
    float o8[8], o9[8];
#pragma unroll
    for (int e = 0; e < 16; ++e) {
        const float vn = x[e] * rstd * p->sgu_norm_w[lane * 16 + e];
        p->out[OFF_GS + (size_t)b * 1024 + lane * 16 + e] = vn;
        const float r = gu[e] * (w00 * vn + b0);
        if (e < 8) o8[e] = r; else o9[e - 8] = r;
    }
    *(u32x4*)(mix + (size_t)(MP + b) * DM + 1024 + lane * 16) = pack8(o8);
    *(u32x4*)(mix + (size_t)(MP + b) * DM + 1024 + lane * 16 + 8) = pack8(o9);
}

__device__ __forceinline__ void p2_phase(LAS unsigned char* lds, KP p, const bf16* proj, bf16* mix) {
    const int G = gridDim.x;
    for (int u = blockIdx.x; u < 256; u += G) attn_prompt_unit(lds, p, proj, mix, u);
    for (int u = blockIdx.x; u < 256; u += G) sgu_prompt_unit(lds, p, proj, mix, u);
    const int tid = tid_fresh(), lane = tid & 63, wave = tid >> 6, gw = blockIdx.x * 8 + wave, NGW = G * 8;
    LAS float* wl = (LAS float*)lds + wave * 256;
    for (int it = gw; it < 512 + 32; it += NGW) {
        if (it < 512) sample_attn_item(wl, p, proj, mix, it, lane);
        else sample_sgu_item(p, proj, mix, it - 512, lane);
    }
    for (int idx = blockIdx.x * 512 + tid; idx < MS * 127 * 64; idx += G * 512) {
        const int bb = idx / (127 * 64), rem = idx - bb * (127 * 64), j = rem >> 6, c4 = (rem & 63) * 4;
        const size_t src = ((size_t)(bb * 128 + j + 1)) * 256 + c4, dst = ((size_t)(bb * 128 + j)) * 256 + c4;
        *(f32x4*)(p->out + OFF_KS + dst) = *(const f32x4*)(p->st_k + src);
        *(f32x4*)(p->out + OFF_VS + dst) = *(const f32x4*)(p->st_v + src);
    }
    __syncthreads();
    {
        constexpr int FIRST = (512 + MS + 7) / 8;
        const int f = ((int)gridDim.x > 2 * FIRST) ? FIRST : 0;
        if ((int)blockIdx.x >= f) convert_items(lds, p, I_EARLY, I_MID, ((int)blockIdx.x - f) * 8 + __builtin_amdgcn_readfirstlane(wave), ((int)gridDim.x - f) * 8, __builtin_amdgcn_readfirstlane(wave), lane);
    }
    __syncthreads();
}

__device__ __forceinline__ void conv_fix_phase(KP p, const float* hb, const float* hs, bf16* act) {
    const int NT = gridDim.x * 512;
    constexpr int NCG = DFF / 8, NPR = 28 * 2;
    for (int it = blockIdx.x * 512 + tid_fresh(); it < NCG * (NPR + MS); it += NT) {
        const int cgp = it % NCG, ri = it / NCG, ch = cgp * 8, colg = (ch >> 7) * 256 + (ch & 127), colu = colg + 128;
        float wg0[8], wg1[8], wg2[8], bg[8], wu0[8], wu1[8], wu2[8], bu[8];
        ld8f(p->conv_w + ch, wg0); ld8f(p->conv_w + NUP + ch, wg1); ld8f(p->conv_w + 2 * NUP + ch, wg2); ld8f(p->conv_b + ch, bg);
        ld8f(p->conv_w + DFF + ch, wu0); ld8f(p->conv_w + NUP + DFF + ch, wu1); ld8f(p->conv_w + 2 * NUP + DFF + ch, wu2); ld8f(p->conv_b + DFF + ch, bu);
        float g2[8], g1[8], g0[8], u2[8], u1[8], u0[8], o[8];
        size_t orow;
        if (ri < NPR) {
            const int k = ri >> 1, rr = ri & 1, pm = (k / 7) * 8 + (k % 7) + 1;
            const float* h2 = rr == 0 ? hb + ((size_t)((pm - 1) * 4 + 2)) * NUP : hb + ((size_t)((pm - 1) * 4 + 3)) * NUP;
            const float* h1 = rr == 0 ? hb + ((size_t)((pm - 1) * 4 + 3)) * NUP : hb + ((size_t)(pm * 4 + 0)) * NUP;
            const float* h0 = hb + ((size_t)(pm * 4 + rr)) * NUP;
            ld8f(h2 + colg, g2); ld8f(h1 + colg, g1); ld8f(h0 + colg, g0); ld8f(h2 + colu, u2); ld8f(h1 + colu, u1); ld8f(h0 + colu, u0);
            orow = (size_t)pm * 256 + rr;
        } else {
            const int bb = ri - NPR;
            const float* st = p->st_conv + (size_t)bb * 2 * NUP;
            ld8f(st + ch, g2); ld8f(st + NUP + ch, g1); ld8f(st + DFF + ch, u2); ld8f(st + NUP + DFF + ch, u1);
            ld8f(hs + (size_t)bb * NUP + colg, g0); ld8f(hs + (size_t)bb * NUP + colu, u0);
            st8f(p->out + OFF_CS + (size_t)bb * 2 * NUP + ch, g1); st8f(p->out + OFF_CS + (size_t)bb * 2 * NUP + DFF + ch, u1);
            orow = (size_t)MP + bb;
        }
#pragma unroll
        for (int e = 0; e < 8; ++e) {
            const float hg = wg0[e] * g2[e] + wg1[e] * g1[e] + wg2[e] * g0[e] + bg[e];
            const float hu = wu0[e] * u2[e] + wu1[e] * u1[e] + wu2[e] * u0[e] + bu[e];
            o[e] = silu_(hg) * hu;
        }
        *(u32x4*)(act + orow * DFF + ch) = pack8(o);
    }
}

__device__ __forceinline__ void bubble_convert(LAS unsigned char* lds, KP p, int first, int lo, int hi) {
    if ((int)blockIdx.x < first) return;
    const int tid = tid_fresh(), lane = tid & 63, wave = __builtin_amdgcn_readfirstlane(tid >> 6);
    convert_items(lds, p, lo, hi, ((int)blockIdx.x - first) * 8 + wave, ((int)gridDim.x - first) * 8, wave, lane);
    __syncthreads();
}
#define XB_TMO      128
#define XB_XCNT(j)  (256  + 64 * (j))
#define XB_XSUB(j)  (1280 + 64 * (j))
#define XB_XGEN(j)  (2304 + 64 * (j))
#define XB_TOP      3328
#define XB_TOPGEN   3392
#define XCD_BAR_WORDS 3456
#define XB_SPIN_CAP (1u << 18)

__device__ __forceinline__ unsigned xb_ld(unsigned* p)              { return __hip_atomic_load(p, __ATOMIC_RELAXED, __HIP_MEMORY_SCOPE_AGENT); }
__device__ __forceinline__ unsigned xb_add(unsigned* p, unsigned v) { return __hip_atomic_fetch_add(p, v, __ATOMIC_RELAXED, __HIP_MEMORY_SCOPE_AGENT); }
__device__ __forceinline__ unsigned xb_xcc_id() { return (unsigned)__builtin_amdgcn_s_getreg((3 << 11) | 20) & 0xFu; }
#define XB_SPIN(cond, bar) do { unsigned _sp = 0; while (cond) { __builtin_amdgcn_s_sleep(1); \
    if ((++_sp & 255u) == 0u) { if (xb_ld(&(bar)[XB_TMO])) break; if (_sp > XB_SPIN_CAP) { atomicAdd(&(bar)[XB_TMO], 1u); break; } } } } while (0)

struct XcdBarrier {
    unsigned* bar; unsigned x;
    volatile LAS unsigned* st;
};

__device__ __forceinline__ XcdBarrier xcd_barrier_post(unsigned* bar, volatile LAS unsigned* st) {
    XcdBarrier b; b.bar = bar; b.x = xb_xcc_id(); b.st = st;
    if (threadIdx.x == 0) (void)xb_add(&bar[XB_XCNT(b.x)], 1u);
    return b;
}
__device__ __forceinline__ void xcd_barrier_complete(unsigned* bar, unsigned x, unsigned& nloc, unsigned& nx) {
    const unsigned G = gridDim.x * gridDim.y * gridDim.z;
    unsigned sum, cnt, mine, sp = 0u;
    for (;;) {
        sum = 0u; cnt = 0u; mine = 0u;
#pragma unroll
        for (unsigned j = 0; j < 16; ++j) { const unsigned c = xb_ld(&bar[XB_XCNT(j)]); sum += c; cnt += (c > 0u) ? 1u : 0u; mine = (j == x) ? c : mine; }
        if (sum == G) break;
        __builtin_amdgcn_s_sleep(1);
        if ((++sp & 255u) == 0u) { if (xb_ld(&bar[XB_TMO])) break; if (sp > XB_SPIN_CAP) { atomicAdd(&bar[XB_TMO], 1u); break; } }
    }
    nloc = mine > 0u ? mine : 1u; nx = cnt > 0u ? cnt : 1u;
}

__device__ __forceinline__ void xcd_barrier(const XcdBarrier& b) {
    asm volatile("s_waitcnt vmcnt(0)" ::: "memory");
    __syncthreads();
    if (threadIdx.x == 0) {
        unsigned* bar = b.bar;
        __builtin_amdgcn_s_waitcnt(0);
        unsigned nloc = b.st[0], nx = b.st[1];
        if (nloc == 0u) { xcd_barrier_complete(bar, b.x, nloc, nx); b.st[0] = nloc; b.st[1] = nx; }
        const unsigned old = xb_add(&bar[XB_XSUB(b.x)], 1u);
        const unsigned gen = old / nloc;
        if (old + 1u == (gen + 1u) * nloc) {
            __builtin_amdgcn_fence(__ATOMIC_RELEASE, "agent");
            asm volatile("s_waitcnt vmcnt(0)" ::: "memory");
            const unsigned og = xb_add(&bar[XB_TOP], 1u);
            const unsigned tg = og / nx;
            if (og + 1u == (tg + 1u) * nx) xb_add(&bar[XB_TOPGEN], 1u);
            else XB_SPIN(xb_ld(&bar[XB_TOPGEN]) == tg, bar);
            __builtin_amdgcn_fence(__ATOMIC_ACQUIRE, "agent");
            xb_add(&bar[XB_XGEN(b.x)], 1u);
            asm volatile("s_waitcnt vmcnt(0)" ::: "memory");
        } else {
            XB_SPIN(xb_ld(&bar[XB_XGEN(b.x)]) == gen, bar);
            __builtin_amdgcn_fence(__ATOMIC_ACQUIRE, "agent");
            asm volatile("s_waitcnt vmcnt(0)" ::: "memory");
        }
    }
    __syncthreads();
}


__global__ void __launch_bounds__(512, 2) fwd_mega(Params p_unused) {
    extern __shared__ __attribute__((aligned(16))) unsigned char lds_raw[];
    LAS unsigned char* lds = (LAS unsigned char*)lds_raw;
    cg::grid_group grid = cg::this_grid();
    if (threadIdx.x < 64) ((LAS unsigned*)(lds + MISC_OFF))[threadIdx.x] = 0u;
    __syncthreads();
    if (gridDim.x > 65535u) grid.sync();
    { KP p = kargs(); (void)xcd_barrier_post((unsigned*)(p->ws + WS_BAR), (volatile LAS unsigned*)(lds + MISC_OFF)); }
#define WSP(T, off) ((T*)(ws + (off)))
#define XSYNC() do { KP p_ = kargs(); XcdBarrier b_; b_.bar = (unsigned*)(p_->ws + WS_BAR); b_.x = xb_xcc_id(); b_.st = (volatile LAS unsigned*)(lds + MISC_OFF); xcd_barrier(b_); } while (0)
#define REP(k) for (int rep_ = 0; rep_ < ((DUP_PHASE == (k)) ? 2 : 1); ++rep_)
    REP(0) { KP p = kargs(); p0_phase(lds, p); }
    XSYNC();
    REP(1) { KP p = kargs(); unsigned char* ws = p->ws; E1 e{WSP(bf16, WS_PROJ), p->b_gate, p->out};
      big_gemm(lds, WSP(bf16, WS_XN), DM, WSP(bf16, WS_W1), DM, N1, DM, e); small_gemm(lds, WSP(bf16, WS_XN) + (size_t)MP * DM, DM, WSP(bf16, WS_W1), DM, N1, DM, e);
      bubble_convert(lds, p, (MP / 256 * (N1 / 256)) % (int)gridDim.x, I_MID, I_MID + I_UP); }
    XSYNC();
    REP(2) { KP p = kargs(); unsigned char* ws = p->ws; p2_phase(lds, p, WSP(bf16, WS_PROJ), WSP(bf16, WS_MIX)); }
    XSYNC();
    { KP p = kargs(); unsigned char* ws = p->ws;
      EpiMerge em{WSP(bf16, WS_PROJ), WSP(bf16, WS_MERGED)};
      pg8::Gemm g{WSP(bf16, WS_MIX), WSP(bf16, WS_WBA), MP, DM, DM, DM, DM}; pg8::StaticOrder S; S.init(MP, DM, (int)gridDim.x, (int)blockIdx.x);
      pg8::gemm_phase<EpiMerge, pg8::StaticOrder, true, true>(lds, g, S, em);
      E2s es{WSP(bf16, WS_PROJ), WSP(bf16, WS_MERGED)};
      small_gemm_dual(lds, WSP(bf16, WS_MIX) + (size_t)MP * DM, DM, WSP(bf16, WS_WBA), DM, DM, es); }
    XSYNC();
    REP(4) { KP p = kargs(); unsigned char* ws = p->ws; E3 e{p->x_prompt, p->x_sample, (bf16*)(p->out + OFF_Y), p->ffn_norm_w, WSP(bf16, WS_XN), WSP(float, WS_SS1)};
      big_gemm(lds, WSP(bf16, WS_MERGED), DM, WSP(bf16, WS_WOUT), DM, DM, DM, e); small_gemm(lds, WSP(bf16, WS_MERGED) + (size_t)MP * DM, DM, WSP(bf16, WS_WOUT), DM, DM, DM, e); }
    XSYNC();
    { KP p = kargs(); unsigned char* ws = p->ws;
      EpiConv ec{WSP(bf16, WS_ACT), p->out, WSP(float, WS_SS1), p->conv_w, p->conv_b, WSP(float, WS_HB), (LAS float*)(lds + 131072)};
      pg8::Gemm g{(const bf16*)(p->out + OFF_Y), WSP(bf16, WS_WUP), MP, NUP, DM, DM, DM};   pg8::StaticOrder S; S.init(MP, NUP, (int)gridDim.x, (int)blockIdx.x);
      pg8::gemm_phase<EpiConv, pg8::StaticOrder, true, true>(lds, g, S, ec);
      E4s e{WSP(float, WS_HS), p->out, WSP(float, WS_SS1)};
      small_gemm(lds, (const bf16*)(p->out + OFF_Y) + (size_t)MP * DM, DM, WSP(bf16, WS_WUP), DM, NUP, DM, e);
      const int first6 = (MP / 256 * (NUP / 256)) % (int)gridDim.x;
      bubble_convert(lds, p, first6, I_MID + I_UP, NITEMS);
      if ((int)blockIdx.x >= first6) {
          E6a e6{WSP(bf16, WS_PP)}; EpiAd<E6a> E{e6};
          pg8::Gemm g2{WSP(bf16, WS_PBF), WSP(bf16, WS_WPP), MP, DM, PLE, PLE, PLE}; pg8::StaticOrder S2; S2.init(MP, DM, (int)gridDim.x - first6, (int)blockIdx.x - first6);
          pg8::gemm_phase<EpiAd<E6a>, pg8::StaticOrder, true, true>(lds, g2, S2, E);
      }
      { E6a e6{WSP(bf16, WS_PP)}; small_gemm(lds, WSP(bf16, WS_PBF) + (size_t)MP * PLE, PLE, WSP(bf16, WS_WPP), PLE, DM, PLE, e6); } }
    XSYNC();
    { KP p = kargs(); unsigned char* ws = p->ws; conv_fix_phase(p, WSP(float, WS_HB), WSP(float, WS_HS), WSP(bf16, WS_ACT)); }
    XSYNC();
    { KP p = kargs(); unsigned char* ws = p->ws; E5 e{(const bf16*)(p->out + OFF_Y), WSP(bf16, WS_XN), p->ple_norm_w, WSP(bf16, WS_XN3), WSP(float, WS_SS2)};
      big_gemm(lds, WSP(bf16, WS_ACT), DFF, WSP(bf16, WS_WDOWN), DFF, DM, DFF, e); small_gemm(lds, WSP(bf16, WS_ACT) + (size_t)MP * DFF, DFF, WSP(bf16, WS_WDOWN), DFF, DM, DFF, e); }
    XSYNC();
    { KP p = kargs(); unsigned char* ws = p->ws; E6b e{WSP(bf16, WS_PP), WSP(bf16, WS_XN), p->out + OFF_Y, WSP(float, WS_SS2)};
      big_gemm(lds, WSP(bf16, WS_XN), DM, WSP(bf16, WS_WPG), DM, DM, DM, e); small_gemm(lds, WSP(bf16, WS_XN) + (size_t)MP * DM, DM, WSP(bf16, WS_WPG), DM, DM, DM, e);   }
#undef WSP
}

extern "C" void kernel_launch(void* const* d_in, const int* in_sizes, int n_in, void* d_out, int out_size, void* d_ws, size_t ws_size, hipStream_t stream) {
    static int grid = 0;
    if (grid == 0) {
        if (n_in != 28 || out_size != (int)OUT_TOTAL || ws_size < WS_END) { fprintf(stderr, "kernel_launch: unexpected shapes: n_in %d out %d ws %zu\n", n_in, out_size, ws_size); grid = -1; return; }
        int dev = 0, cus = 0, per_cu = 0;
        (void)hipGetDevice(&dev); (void)hipDeviceGetAttribute(&cus, hipDeviceAttributeMultiprocessorCount, dev);
        if (hipFuncSetAttribute((const void*)fwd_mega, hipFuncAttributeMaxDynamicSharedMemorySize, LDS_BYTES) != hipSuccess) { fprintf(stderr, "kernel_launch: hipFuncSetAttribute failed\n"); grid = -1; return; }
        if (hipOccupancyMaxActiveBlocksPerMultiprocessor(&per_cu, (const void*)fwd_mega, 512, LDS_BYTES) != hipSuccess || per_cu < 1) { fprintf(stderr, "kernel_launch: occupancy query says %d\n", per_cu); per_cu = 1; }
        (void)hipGetLastError();
        grid = cus * 1;
    }
    if (grid < 0) return;
    Params p{};
    const float** pp = (const float**)&p;
    for (int i = 0; i < 28; ++i) pp[i] = (const float*)d_in[i];
    p.out = (float*)d_out; p.ws = (unsigned char*)d_ws;
    if (hipMemsetAsync((char*)d_ws + WS_BAR, 0, XCD_BAR_WORDS * 4, stream) != hipSuccess) { fprintf(stderr, "kernel_launch: memset of the barrier words failed\n"); return; }
    void* args[] = {&p};
    hipError_t e = hipLaunchCooperativeKernel((const void*)fwd_mega, dim3(grid), dim3(512), args, LDS_BYTES, stream);
    if (e != hipSuccess) fprintf(stderr, "kernel_launch: cooperative launch failed: %s (grid %d)\n", hipGetErrorString(e), grid);
}
```
